# Optimizing an MI355X kernel written in HIP

```python
import math
import jax, jax.numpy as jnp
from jax import lax
import numpy as np

D_MODEL = 1024
BATCH = 8
SEQ = 2048
DEPTH = 1

D_MIX = D_MODEL
D_ATTN = D_MIX // 2
D_POOL = D_MIX - D_ATTN
N_DIFF_HEADS = 4
DIFF_QK_DIM = D_ATTN // (2 * N_DIFF_HEADS)
DIFF_V_DIM = 2 * DIFF_QK_DIM
POOL_WINDOWS = (2, 4, 8, 16)
N_POOL_GROUPS = len(POOL_WINDOWS)
POOL_GROUP_DIM = D_POOL // N_POOL_GROUPS
D_IN_PROJ = 3 * D_ATTN + D_POOL
N_EXPERTS = 32
TOP_K = 4
D_FF = D_MODEL
SWIGLU_LIMIT = 7.0
SWIGLU_ALPHA = 1.702
Q_BLOCK = 128
MOE_BLOCK = 128
RMS_EPS = 1e-5

kernel_name = "hymba_style_diffattn_pool_moe_block"


def rmsnorm(x, g):
    xf = x.astype(jnp.float32)
    y = xf * lax.rsqrt(jnp.mean(xf * xf, axis=-1, keepdims=True) + RMS_EPS)
    return (y * g.astype(jnp.float32)).astype(x.dtype)


def diff_attention(q, k, v, lam, subln_g, lambda_init):
    B, S, H, _, DK = q.shape
    nb = S // Q_BLOCK
    qb = jnp.moveaxis(q.reshape(B, nb, Q_BLOCK, H, 2, DK), 1, 0)
    key_pos = jnp.arange(S)
    scale = DK ** -0.5

    def one_block(args):
        i, q_i = args
        q_pos = i * Q_BLOCK + jnp.arange(Q_BLOCK)
        s = jnp.einsum('bqhmd,bkhmd->bhmqk', q_i, k,
                       preferred_element_type=jnp.float32) * scale
        causal = key_pos[None, :] <= q_pos[:, None]
        s = jnp.where(causal, s, -jnp.inf)
        p = jax.nn.softmax(s, axis=-1)
        a = p[:, :, 0] - lam * p[:, :, 1]
        return jnp.einsum('bhqk,bkhd->bqhd', a.astype(v.dtype), v)

    o = lax.map(one_block, (jnp.arange(nb), qb))
    o = jnp.moveaxis(o, 0, 1).reshape(B, S, H, DIFF_V_DIM)
    o = rmsnorm(o, subln_g) * (1.0 - lambda_init)
    return o.reshape(B, S, H * DIFF_V_DIM)


def multiscale_pool(u, w_pool, b_pool, pool_scale):
    B, S, _ = u.shape
    uf = u.astype(jnp.float32).reshape(B, S, N_POOL_GROUPS, POOL_GROUP_DIM)
    csum = jnp.cumsum(uf, axis=1)
    pos1 = jnp.arange(1, S + 1)
    outs = []
    for g, w in enumerate(POOL_WINDOWS):
        c = csum[:, :, g]
        c_prev = jnp.pad(c, ((0, 0), (w, 0), (0, 0)))[:, :S]
        cnt = jnp.minimum(pos1, w).astype(jnp.float32)[None, :, None]
        outs.append((c - c_prev) / cnt - uf[:, :, g])
    z = jnp.stack(outs, axis=2).astype(u.dtype)
    y = jnp.einsum('bsgc,gcd->bsgd', z, w_pool) + b_pool
    return y.reshape(B, S, D_POOL) * pool_scale


def moe(h, router_w, router_b, w_gate, b_gate, w_up, b_up, w_down, b_down):
    T = h.shape[0]
    logits = (h @ router_w + router_b).astype(jnp.float32)
    top_vals, top_idx = lax.top_k(logits, TOP_K)
    gates = jax.nn.softmax(top_vals, axis=-1)
    A = T * TOP_K
    flat_e = top_idx.reshape(A)
    flat_tok = jnp.arange(A, dtype=jnp.int32) // TOP_K
    flat_g = gates.reshape(A)
    order = jnp.argsort(flat_e)
    sorted_e = flat_e[order]
    counts = jnp.bincount(flat_e, length=N_EXPERTS)
    padded = ((counts + MOE_BLOCK - 1) // MOE_BLOCK) * MOE_BLOCK
    group_start = jnp.cumsum(counts) - counts
    padded_end = jnp.cumsum(padded)
    padded_start = padded_end - padded
    dest = padded_start[sorted_e] + (jnp.arange(A) - group_start[sorted_e])
    n_blocks = (A + N_EXPERTS * (MOE_BLOCK - 1) + MOE_BLOCK - 1) // MOE_BLOCK
    P = n_blocks * MOE_BLOCK
    slot_tok = jnp.zeros((P,), jnp.int32).at[dest].set(flat_tok[order])
    slot_gate = jnp.zeros((P,), jnp.float32).at[dest].set(flat_g[order])
    block_expert = jnp.clip(
        jnp.searchsorted(padded_end, jnp.arange(n_blocks) * MOE_BLOCK, side='right'),
        0, N_EXPERTS - 1)

    def expert_block(args):
        e, tok, g = args
        xb = h[tok]
        gate = jnp.minimum(xb @ w_gate[e] + b_gate[e], SWIGLU_LIMIT)
        up = jnp.clip(xb @ w_up[e] + b_up[e], -SWIGLU_LIMIT, SWIGLU_LIMIT)
        act = gate * jax.nn.sigmoid(SWIGLU_ALPHA * gate) * (up + 1.0)
        y = act @ w_down[e] + b_down[e]
        return y * g.astype(y.dtype)[:, None]

    ys = lax.map(expert_block, (block_expert,
                                slot_tok.reshape(n_blocks, MOE_BLOCK),
                                slot_gate.reshape(n_blocks, MOE_BLOCK)))
    return jnp.zeros_like(h).at[slot_tok].add(ys.reshape(P, h.shape[1]))


def setup_inputs(seed: int = 0) -> dict:
    key = jax.random.key(seed)
    ks = jax.random.split(key, 24)
    f32 = jnp.float32
    L = DEPTH

    def nrm(k, shape, scale):
        return jax.random.normal(k, shape, f32) * scale

    return {
        "x": nrm(ks[0], (BATCH, SEQ, D_MODEL), 1.0),
        "norm1_g": 1.0 + nrm(ks[1], (L, D_MODEL), 0.02),
        "w_in": nrm(ks[2], (L, D_MODEL, D_IN_PROJ), D_MODEL ** -0.5),
        "lambda_q1": nrm(ks[3], (L, DIFF_QK_DIM), 0.1),
        "lambda_k1": nrm(ks[4], (L, DIFF_QK_DIM), 0.1),
        "lambda_q2": nrm(ks[5], (L, DIFF_QK_DIM), 0.1),
        "lambda_k2": nrm(ks[6], (L, DIFF_QK_DIM), 0.1),
        "subln_g": 1.0 + nrm(ks[7], (L, DIFF_V_DIM), 0.02),
        "w_pool": nrm(ks[8], (L, N_POOL_GROUPS, POOL_GROUP_DIM, POOL_GROUP_DIM), POOL_GROUP_DIM ** -0.5),
        "b_pool": nrm(ks[9], (L, N_POOL_GROUPS, POOL_GROUP_DIM), 0.01),
        "pool_scale": 1.0 + nrm(ks[10], (L, D_POOL), 0.02),
        "w_out": nrm(ks[11], (L, D_MIX, D_MODEL), D_MIX ** -0.5),
        "norm2_g": 1.0 + nrm(ks[12], (L, D_MODEL), 0.02),
        "router_w": nrm(ks[13], (L, D_MODEL, N_EXPERTS), D_MODEL ** -0.5),
        "router_b": nrm(ks[14], (L, N_EXPERTS), 0.01),
        "w_gate": nrm(ks[15], (L, N_EXPERTS, D_MODEL, D_FF), D_MODEL ** -0.5),
        "b_gate": nrm(ks[16], (L, N_EXPERTS, D_FF), 0.01),
        "w_up": nrm(ks[17], (L, N_EXPERTS, D_MODEL, D_FF), D_MODEL ** -0.5),
        "b_up": nrm(ks[18], (L, N_EXPERTS, D_FF), 0.01),
        "w_down": nrm(ks[19], (L, N_EXPERTS, D_FF, D_MODEL), D_FF ** -0.5),
        "b_down": nrm(ks[20], (L, N_EXPERTS, D_MODEL), 0.01),
        "final_g": 1.0 + nrm(ks[21], (D_MODEL,), 0.02),
    }


def reference(x, norm1_g, w_in, lambda_q1, lambda_k1, lambda_q2, lambda_k2, subln_g,
              w_pool, b_pool, pool_scale, w_out, norm2_g, router_w, router_b,
              w_gate, b_gate, w_up, b_up, w_down, b_down, final_g):
    B, S, D = x.shape
    for l in range(DEPTH):
        lambda_init = 0.8 - 0.6 * math.exp(-0.3 * l)
        lam = (jnp.exp(jnp.sum(lambda_q1[l].astype(jnp.float32) * lambda_k1[l].astype(jnp.float32)))
               - jnp.exp(jnp.sum(lambda_q2[l].astype(jnp.float32) * lambda_k2[l].astype(jnp.float32)))
               + lambda_init)
        h = rmsnorm(x, norm1_g[l])
        proj = h @ w_in[l]
        q, k, v, u = jnp.split(proj, [D_ATTN, 2 * D_ATTN, 3 * D_ATTN], axis=-1)
        q = q.reshape(B, S, N_DIFF_HEADS, 2, DIFF_QK_DIM)
        k = k.reshape(B, S, N_DIFF_HEADS, 2, DIFF_QK_DIM)
        v = v.reshape(B, S, N_DIFF_HEADS, DIFF_V_DIM)
        attn_out = diff_attention(q, k, v, lam, subln_g[l], lambda_init)
        pool_out = multiscale_pool(u, w_pool[l], b_pool[l], pool_scale[l])
        x = x + jnp.concatenate([attn_out, pool_out], axis=-1) @ w_out[l]
        h = rmsnorm(x, norm2_g[l])
        y = moe(h.reshape(B * S, D), router_w[l], router_b[l], w_gate[l], b_gate[l],
                w_up[l], b_up[l], w_down[l], b_down[l])
        x = x + y.reshape(B, S, D)
    return rmsnorm(x, final_g)
```

```cpp
#include <hip/hip_runtime.h>
#include <hip/hip_cooperative_groups.h>
#include <cstdio>
#include <cstdint>
namespace cg = cooperative_groups;

#ifndef MK_N_LAUNCHES
#define MK_N_LAUNCHES 1
#endif

#define LAS __attribute__((address_space(3)))
#define GAS __attribute__((address_space(1)))
typedef unsigned short bf16_t;
typedef short bf16x8 __attribute__((ext_vector_type(8)));
typedef short s16x4 __attribute__((ext_vector_type(4)));
typedef float f32x4 __attribute__((ext_vector_type(4)));
typedef float f32x2 __attribute__((ext_vector_type(2)));
typedef float f32x16 __attribute__((ext_vector_type(16)));
typedef unsigned u32x4 __attribute__((ext_vector_type(4)));
typedef unsigned u32x2 __attribute__((ext_vector_type(2)));
typedef __bf16 bf16x2_t __attribute__((ext_vector_type(2)));

constexpr int BATCH = 8, SEQ = 2048, D = 1024, M = BATCH * SEQ;
constexpr int NIN = 2048;
constexpr int NE = 32, TOPK = 4, DFF = 1024;
constexpr int NSLOT = M * TOPK;
constexpr int PADROWS = NSLOT + NE * 256;
constexpr float RMS_EPS = 1e-5f;
constexpr float QSCALE = 0.125f * 1.4426950408889634f;
constexpr float LAMBDA_INIT = 0.2f;

constexpr size_t MiB = 1u << 20;
constexpr size_t WS_CTL = 0, CTL_ZERO_BYTES = 1 * MiB;
constexpr size_t WS_WIN = 1 * MiB;
constexpr size_t WS_WOUT = 5 * MiB;
constexpr size_t WS_WPOOL = 7 * MiB;
constexpr size_t WS_TOKE = 8 * MiB;
constexpr size_t WS_TOKP = WS_TOKE + 256 * 1024;
constexpr size_t WS_LTOK = 9 * MiB;
constexpr size_t WS_LGATE = 11 * MiB;
constexpr size_t WS_WD = 16 * MiB;
constexpr size_t WS_WGU = 80 * MiB;
constexpr size_t WS_ACT = 208 * MiB;
constexpr size_t WS_XN = 352 * MiB;
constexpr size_t WS_QKVU = 384 * MiB;
constexpr size_t WS_MIX = 448 * MiB;
constexpr size_t WS_Y = 352 * MiB;
constexpr size_t WS_END = 496 * MiB;
constexpr int CW_CNT = 64;
constexpr int CW_BAR = 4096;

constexpr int RING_BYTES = 131072;
constexpr int LDSX_OFF = RING_BYTES;
constexpr int LDS_BYTES = 147456;

__device__ __forceinline__ unsigned pk2(float lo, float hi) { f32x2 v = {lo, hi}; bf16x2_t b = __builtin_convertvector(v, bf16x2_t); return __builtin_bit_cast(unsigned, b); }
__device__ __forceinline__ float bf2f(unsigned short h) { return __uint_as_float(((unsigned)h) << 16); }
__device__ __forceinline__ float wave_sum(float v) {
#pragma unroll
    for (int o = 1; o < 64; o <<= 1) v += __shfl_xor(v, o);
    return v;
}
__device__ __forceinline__ float wave_max(float v) {
#pragma unroll
    for (int o = 1; o < 64; o <<= 1) v = fmaxf(v, __shfl_xor(v, o));
    return v;
}
__device__ __forceinline__ int wave_min_i(int v) {
#pragma unroll
    for (int o = 1; o < 64; o <<= 1) { int w = __shfl_xor(v, o); v = w < v ? w : v; }
    return v;
}

namespace pg8 {
constexpr int BM = 256, BK = 64, HALF = 128, HTB = HALF * BK * 2, STAGE_BYTES = 8 * HTB;
__device__ __forceinline__ int lds_byte(int r, int c) { const int st = (r >> 4) * 2 + (c >> 5), rr = r & 15, cc = c & 31, ob = rr * 64 + cc * 2; return st * 1024 + (ob ^ (((ob >> 9) & 1) << 5)); }
__device__ __forceinline__ void stage_rc(int b, int& R, int& C) { const int st = b / 1024, sb = b % 1024, swz = sb ^ (((sb >> 9) & 1) << 5); R = (st >> 1) * 16 + swz / 64; C = (st & 1) * 32 + (swz % 64) / 2; }
__device__ __forceinline__ int perm32(int rho) { const int n = rho >> 4, i = rho & 15; return 8 * (i >> 2) + 4 * n + (i & 3); }

struct Unit { int pm, pn, e; unsigned a00, a01, a10, a11; const char* B; };

template <class Epi, class Sched, bool ALIGN_EPI>
__device__ __forceinline__ void gemm_phase(LAS unsigned char* lds, const char* A, const int K, const Sched& S, const Epi& E) {
    const int tid = threadIdx.x, wid = __builtin_amdgcn_readfirstlane(tid >> 6), lane = tid & 63, wr = wid >> 2, wc = wid & 3, fr = lane & 15, fq = lane >> 4;
    const int nt = K / BK;
    int R0, C0, R1, C1; stage_rc(tid * 16, R0, C0); stage_rc(tid * 16 + 8192, R1, C1);
    unsigned voffB[2];
    { const int Rb0 = Epi::PERM ? ((R0 & ~31) + perm32(R0 & 31)) : R0, Rb1 = Epi::PERM ? ((R1 & ~31) + perm32(R1 & 31)) : R1;
      voffB[0] = (unsigned)(Rb0 * K + C0) * 2u; voffB[1] = (unsigned)(Rb1 * K + C1) * 2u; }
    const size_t kstep = (size_t)(BK * 2);
    const size_t hstep = (size_t)HALF * K * 2;
    const unsigned ldsw = (unsigned)wid * 1024u;
    const int aoff = lds_byte(wr * 64 + fr, fq * 8), boff = lds_byte(wc * 32 + fr, fq * 8);
#define PG8_SA(b, h) (((b) * 2 + (h)) * HTB)
#define PG8_SB(b, h) ((4 + (b) * 2 + (h)) * HTB)
#define PG8_STAGEB(bufoff, gbase) do { _Pragma("unroll") for (int _i = 0; _i < 2; ++_i) \
        __builtin_amdgcn_global_load_lds((const unsigned*)((const char*)(gbase) + voffB[_i]), (LAS unsigned*)(lds + (bufoff) + ldsw + _i * 8192), 16, 0, 0); } while (0)
#define PG8_STAGEA(bufoff, kb, o0, o1) do { \
        __builtin_amdgcn_global_load_lds((const unsigned*)(A + (size_t)(o0) + (kb)), (LAS unsigned*)(lds + (bufoff) + ldsw), 16, 0, 0); \
        __builtin_amdgcn_global_load_lds((const unsigned*)(A + (size_t)(o1) + (kb)), (LAS unsigned*)(lds + (bufoff) + ldsw + 8192), 16, 0, 0); } while (0)
#define PG8_LDA(dst, b, h) do { _Pragma("unroll") for (int m = 0; m < 4; ++m) _Pragma("unroll") for (int k = 0; k < 2; ++k) dst[m][k] = *(const LAS bf16x8*)(lds + PG8_SA(b, h) + aoff + m * 2048 + k * 1024); } while (0)
#define PG8_LDB(dst, b, h) do { _Pragma("unroll") for (int n = 0; n < 2; ++n) _Pragma("unroll") for (int k = 0; k < 2; ++k) dst[n][k] = *(const LAS bf16x8*)(lds + PG8_SB(b, h) + boff + n * 2048 + k * 1024); } while (0)
#define PG8_MMA(ai, bj, At, Bt) do { __builtin_amdgcn_s_setprio(1); _Pragma("unroll") for (int m = 0; m < 4; ++m) _Pragma("unroll") for (int n = 0; n < 2; ++n) _Pragma("unroll") for (int k = 0; k < 2; ++k) \
        acc[ai][bj][m][n] = __builtin_amdgcn_mfma_f32_16x16x32_bf16(Bt[n][k], At[m][k], acc[ai][bj][m][n], 0, 0, 0); __builtin_amdgcn_s_setprio(0); } while (0)
#define PG8_WAIT_V(n) asm volatile("s_waitcnt vmcnt(" #n ")" ::: "memory")
#define PG8_WAIT_L(n) asm volatile("s_waitcnt lgkmcnt(" #n ")" ::: "memory")
#define PG8_BAR __builtin_amdgcn_s_barrier()
#define PG8_SCHED __builtin_amdgcn_sched_barrier(0)
    Unit cur, nxt; int ui = 0;
    if (!S.next(0, cur, R0, C0, R1, C1)) return;
    f32x4 acc[2][2][4][2];
#pragma unroll
    for (int a = 0; a < 2; ++a)
#pragma unroll
        for (int b = 0; b < 2; ++b)
#pragma unroll
            for (int m = 0; m < 4; ++m)
#pragma unroll
                for (int n = 0; n < 2; ++n) acc[a][b][m][n] = (f32x4){0.f, 0.f, 0.f, 0.f};
    bf16x8 At[4][2], B0[2][2], B1[2][2];
    const char* cB = cur.B;
    PG8_STAGEB(PG8_SB(0, 0), cB); PG8_STAGEB(PG8_SB(0, 1), cB + hstep); PG8_STAGEA(PG8_SA(0, 0), 0, cur.a00, cur.a01); PG8_STAGEA(PG8_SA(0, 1), 0, cur.a10, cur.a11);
    if (wr == 1) PG8_BAR;
    PG8_WAIT_V(2); PG8_BAR;
    PG8_STAGEB(PG8_SB(1, 0), cB + kstep); PG8_STAGEA(PG8_SA(1, 0), kstep, cur.a00, cur.a01); PG8_STAGEB(PG8_SB(1, 1), cB + hstep + kstep);
    PG8_WAIT_V(6); PG8_BAR;
    for (;;) {
        const bool has_next = S.next(ui + 1, nxt, R0, C0, R1, C1);
        if (!has_next) nxt = cur;
        const char* nB = nxt.B;
        for (int t = 0; t < nt; t += 2) {
            const bool last = (t == nt - 2);
            const size_t k1 = (size_t)(t + 1) * kstep;
            const size_t k2 = last ? 0 : (size_t)(t + 2) * kstep, k3 = k2 + kstep;
            const char* b2 = last ? nB : cB + (size_t)(t + 2) * kstep; const char* b3 = b2 + kstep;
            const unsigned s00 = last ? nxt.a00 : cur.a00, s01 = last ? nxt.a01 : cur.a01, s10 = last ? nxt.a10 : cur.a10, s11 = last ? nxt.a11 : cur.a11;
            PG8_LDB(B0, 0, 0); PG8_LDB(B1, 0, 1); PG8_SCHED; PG8_LDA(At, 0, 0); PG8_STAGEA(PG8_SA(1, 1), k1, cur.a10, cur.a11);
            PG8_WAIT_V(8); PG8_WAIT_L(0); PG8_BAR; PG8_MMA(0, 0, At, B0); PG8_MMA(0, 1, At, B1); PG8_BAR; PG8_SCHED;
            PG8_LDA(At, 0, 1); PG8_STAGEB(PG8_SB(0, 0), b2); PG8_STAGEB(PG8_SB(0, 1), b2 + hstep); PG8_STAGEA(PG8_SA(0, 0), k2, s00, s01);
            PG8_WAIT_V(8); PG8_WAIT_L(0); PG8_BAR; PG8_MMA(1, 0, At, B0); PG8_MMA(1, 1, At, B1); PG8_BAR; PG8_SCHED;
            PG8_LDB(B0, 1, 0); PG8_LDB(B1, 1, 1); PG8_SCHED; PG8_LDA(At, 1, 0); PG8_STAGEA(PG8_SA(0, 1), k2, s10, s11);
            PG8_WAIT_V(8); PG8_WAIT_L(0); PG8_BAR; PG8_MMA(0, 0, At, B0); PG8_MMA(0, 1, At, B1); PG8_BAR; PG8_SCHED;
            PG8_LDA(At, 1, 1); PG8_STAGEB(PG8_SB(1, 0), b3); PG8_STAGEB(PG8_SB(1, 1), b3 + hstep); PG8_STAGEA(PG8_SA(1, 0), k3, s00, s01);
            PG8_WAIT_V(8); PG8_WAIT_L(0); PG8_BAR; PG8_MMA(1, 0, At, B0); PG8_MMA(1, 1, At, B1); PG8_BAR; PG8_SCHED;
        }
        if constexpr (ALIGN_EPI) { if (wr == 0) PG8_BAR; }
        E(acc, cur, wr, wc, fr, fq);
        if (!has_next) break;
#pragma unroll
        for (int a = 0; a < 2; ++a)
#pragma unroll
            for (int b = 0; b < 2; ++b)
#pragma unroll
                for (int m = 0; m < 4; ++m)
#pragma unroll
                    for (int n = 0; n < 2; ++n) acc[a][b][m][n] = (f32x4){0.f, 0.f, 0.f, 0.f};
        cur = nxt; cB = nB; ++ui;
        if constexpr (ALIGN_EPI) { if (wr == 1) PG8_BAR; }
    }
    PG8_WAIT_V(0);
    if constexpr (!ALIGN_EPI) { if (wr == 0) PG8_BAR; }
    PG8_BAR;
#undef PG8_SA
#undef PG8_SB
#undef PG8_STAGEA
#undef PG8_STAGEB
#undef PG8_LDA
#undef PG8_LDB
#undef PG8_MMA
#undef PG8_WAIT_V
#undef PG8_WAIT_L
#undef PG8_BAR
#undef PG8_SCHED
}

struct DenseSched {
    int nM, nN, nwg, G, c, K; const char* Bt;
    __device__ __forceinline__ void init(int Mr, int N, int K_, int G_, int c_, const void* Bt_) { nM = Mr / BM; nN = N / BM; nwg = nM * nN; G = G_; c = c_; K = K_; Bt = (const char*)Bt_; }
    __device__ __forceinline__ bool next(int i, Unit& u, int R0, int C0, int R1, int C1) const {
        const long L = (long)i * G + c; if (L >= nwg) return false;
        int wgid = (int)L; { const int q = nwg / 8, r = nwg % 8, xcd = wgid % 8, off = wgid / 8; wgid = (xcd < r ? xcd * (q + 1) : r * (q + 1) + (xcd - r) * q) + off; }
        const int WGM = 8, nig = WGM * nN, gid = wgid / nig, fm = gid * WGM, gsz = (nM - fm) < WGM ? (nM - fm) : WGM;
        u.pm = fm + ((wgid % nig) % gsz); u.pn = (wgid % nig) / gsz; u.e = 0;
        const unsigned rb = (unsigned)u.pm * 256u;
        u.a00 = ((rb + R0) * K + C0) * 2u; u.a01 = ((rb + R1) * K + C1) * 2u; u.a10 = ((rb + 128 + R0) * K + C0) * 2u; u.a11 = ((rb + 128 + R1) * K + C1) * 2u;
        u.B = Bt + (size_t)u.pn * 256 * K * 2; return true;
    }
};
struct MoeSched {
    const LAS int* tp; const LAS int* cnt; int NT; int xcd, j; int K; const char* W; size_t wstride; const int* ltok; bool gather;
    __device__ __forceinline__ bool next(int i, Unit& u, int R0, int C0, int R1, int C1) const {
        const int U = tp[NE] * NT; const int lo = (int)(((long)xcd * U) / 8), hi = (int)(((long)(xcd + 1) * U) / 8);
        const int L = lo + i * 32 + j; if (L >= hi) return false;
        int e = 0;
        for (int q = 1; q < NE; ++q) e = (L >= tp[q] * NT) ? q : e;
        const int nte = tp[e + 1] - tp[e], r = L - tp[e] * NT, pn = r / nte, mt = r % nte;
        u.e = e; u.pn = pn; u.pm = tp[e] + mt;
        if (gather) {
            const int ce = cnt[e]; const int* lt = ltok + (size_t)e * M;
            const int i00 = mt * 256 + R0, i01 = mt * 256 + R1, i10 = i00 + 128, i11 = i01 + 128;
            const unsigned t00 = i00 < ce ? (unsigned)lt[i00] : 0u, t01 = i01 < ce ? (unsigned)lt[i01] : 0u, t10 = i10 < ce ? (unsigned)lt[i10] : 0u, t11 = i11 < ce ? (unsigned)lt[i11] : 0u;
            u.a00 = (t00 * K + C0) * 2u; u.a01 = (t01 * K + C1) * 2u; u.a10 = (t10 * K + C0) * 2u; u.a11 = (t11 * K + C1) * 2u;
        } else {
            const unsigned rb = (unsigned)u.pm * 256u;
            u.a00 = ((rb + R0) * K + C0) * 2u; u.a01 = ((rb + R1) * K + C1) * 2u; u.a10 = ((rb + 128 + R0) * K + C0) * 2u; u.a11 = ((rb + 128 + R1) * K + C1) * 2u;
        }
        u.B = W + (size_t)e * wstride + (size_t)pn * 256 * K * 2; return true;
    }
};

struct EpiQkvu {
    static constexpr bool PERM = true; bf16_t* O;
    __device__ __forceinline__ void operator()(const f32x4 (&acc)[2][2][4][2], const Unit& u, int wr, int wc, int fr, int fq) const {
        const int row0 = u.pm * BM + wr * 64 + fr, col0 = u.pn * BM + wc * 32 + 8 * fq; const float sc = (u.pn < 2) ? QSCALE : 1.f;
#pragma unroll
        for (int ai = 0; ai < 2; ++ai)
#pragma unroll
            for (int m = 0; m < 4; ++m) { bf16_t* rowp = O + (size_t)(row0 + ai * HALF + m * 16) * NIN + col0;
#pragma unroll
                for (int bj = 0; bj < 2; ++bj) { const f32x4 v0 = acc[ai][bj][m][0] * sc, v1 = acc[ai][bj][m][1] * sc;
                    u32x4 w; w.x = pk2(v0[0], v0[1]); w.y = pk2(v0[2], v0[3]); w.z = pk2(v1[0], v1[1]); w.w = pk2(v1[2], v1[3]);
                    *(u32x4*)(rowp + bj * HALF) = w; } }
    }
};
struct EpiResF32 {
    static constexpr bool PERM = false; const float* base; float* out;
    __device__ __forceinline__ void operator()(const f32x4 (&acc)[2][2][4][2], const Unit& u, int wr, int wc, int fr, int fq) const {
        const int col0 = u.pn * BM + wc * 32 + 4 * fq;
#pragma unroll
        for (int ai = 0; ai < 2; ++ai)
#pragma unroll
            for (int m = 0; m < 4; ++m) { const size_t off = (size_t)(u.pm * BM + ai * HALF + wr * 64 + m * 16 + fr) * D + col0;
#pragma unroll
                for (int bj = 0; bj < 2; ++bj)
#pragma unroll
                    for (int n = 0; n < 2; ++n) { const f32x4 bs = *(const f32x4*)(base + off + bj * HALF + n * 16); *(f32x4*)(out + off + bj * HALF + n * 16) = bs + acc[ai][bj][m][n]; } }
    }
};
struct EpiSwiglu {
    static constexpr bool PERM = true; bf16_t* ACT; const float* bg; const float* bu;
    __device__ __forceinline__ void operator()(const f32x4 (&acc)[2][2][4][2], const Unit& u, int wr, int wc, int fr, int fq) const {
        const int row0 = u.pm * BM + wr * 64 + fr, col0 = u.pn * 128 + wc * 32 + 8 * fq;
        f32x4 g4[2], u4[2];
#pragma unroll
        for (int n = 0; n < 2; ++n) { g4[n] = *(const f32x4*)(bg + (size_t)u.e * DFF + col0 + 4 * n); u4[n] = *(const f32x4*)(bu + (size_t)u.e * DFF + col0 + 4 * n); }
#pragma unroll
        for (int ai = 0; ai < 2; ++ai)
#pragma unroll
            for (int m = 0; m < 4; ++m) { float a[8];
#pragma unroll
                for (int n = 0; n < 2; ++n)
#pragma unroll
                    for (int j = 0; j < 4; ++j) { const float g = fminf(acc[ai][0][m][n][j] + g4[n][j], 7.0f); const float up = fminf(fmaxf(acc[ai][1][m][n][j] + u4[n][j], -7.0f), 7.0f);
                        const float sg = __builtin_amdgcn_rcpf(1.0f + __builtin_amdgcn_exp2f(-1.702f * 1.4426950408889634f * g)); a[n * 4 + j] = g * sg * (up + 1.0f); }
                u32x4 w; w.x = pk2(a[0], a[1]); w.y = pk2(a[2], a[3]); w.z = pk2(a[4], a[5]); w.w = pk2(a[6], a[7]);
                *(u32x4*)(ACT + (size_t)(row0 + ai * HALF + m * 16) * DFF + col0) = w; }
    }
};
struct EpiDown {
    static constexpr bool PERM = true; bf16_t* Y; const float* bd; const float* lgate; const LAS int* tp;
    __device__ __forceinline__ void operator()(const f32x4 (&acc)[2][2][4][2], const Unit& u, int wr, int wc, int fr, int fq) const {
        const int mt = u.pm - tp[u.e]; const int row0 = u.pm * BM + wr * 64 + fr, col0 = u.pn * BM + wc * 32 + 8 * fq;
        const float* lg = lgate + (size_t)u.e * M + mt * 256 + wr * 64 + fr;
        f32x4 bv[2][2];
#pragma unroll
        for (int bj = 0; bj < 2; ++bj)
#pragma unroll
            for (int n = 0; n < 2; ++n) bv[bj][n] = *(const f32x4*)(bd + (size_t)u.e * D + col0 + bj * HALF + 4 * n);
#pragma unroll
        for (int ai = 0; ai < 2; ++ai)
#pragma unroll
            for (int m = 0; m < 4; ++m) { const float gt = lg[ai * HALF + m * 16]; bf16_t* rowp = Y + (size_t)(row0 + ai * HALF + m * 16) * D + col0;
#pragma unroll
                for (int bj = 0; bj < 2; ++bj) { const f32x4 v0 = (acc[ai][bj][m][0] + bv[bj][0]) * gt, v1 = (acc[ai][bj][m][1] + bv[bj][1]) * gt;
                    u32x4 w; w.x = pk2(v0[0], v0[1]); w.y = pk2(v0[2], v0[3]); w.z = pk2(v1[0], v1[1]); w.w = pk2(v1[2], v1[3]);
                    *(u32x4*)(rowp + bj * HALF) = w; } }
    }
};
}

namespace att {
__device__ __forceinline__ int crow(int r, int hi) { return (r & 3) + 8 * (r >> 2) + 4 * hi; }
__device__ __forceinline__ s16x4 vtr(const LAS unsigned char* p) { typedef short v4 __attribute__((ext_vector_type(4))); return __builtin_bit_cast(s16x4, __builtin_amdgcn_ds_read_tr16_b64_v4i16((LAS v4*)p)); }

__device__ __forceinline__ void attn_unit(int b, int h, int qb, const bf16_t* QKVU, bf16_t* MIX, LAS unsigned char* lds, float lam, const float* subln_g) {
    const int tid = threadIdx.x, lane = tid & 63, r32 = lane & 31, hi = lane >> 5; const int wid = __builtin_amdgcn_readfirstlane(tid >> 6);
    const int map = wid >> 2, wq = wid & 3;
    const long rowbase = (long)b * SEQ; const int q0 = qb * 128;
    const int NT = 2 * qb + 2;
    const bf16_t* Qp = QKVU + (size_t)(rowbase + q0 + wq * 32 + r32) * NIN + h * 128 + map * 64 + hi * 8;
    bf16x8 qr[4];
#pragma unroll
    for (int d0 = 0; d0 < 4; ++d0) qr[d0] = *(const bf16x8*)(Qp + d0 * 16);
    const bf16_t* ksrc[2]; const bf16_t* vsrc[2];
#pragma unroll
    for (int i = 0; i < 2; ++i) { const int p = 2 * wid + i;
        ksrc[i] = QKVU + (size_t)(rowbase + lane) * NIN + 512 + h * 128 + (p >> 3) * 64 + (p & 7) * 8;
        vsrc[i] = QKVU + (size_t)(rowbase + 16 * (p & 3) + (lane >> 2)) * NIN + 1024 + h * 128 + (p >> 2) * 32 + (lane & 3) * 8; }
#define ATT_DMA(t, buf) do { _Pragma("unroll") for (int _i = 0; _i < 2; ++_i) { \
        __builtin_amdgcn_global_load_lds((const unsigned*)(ksrc[_i] + (size_t)(t) * 64 * NIN), (LAS unsigned*)(lds + (buf) * 32768 + (2 * wid + _i) * 1024), 16, 0, 0); \
        __builtin_amdgcn_global_load_lds((const unsigned*)(vsrc[_i] + (size_t)(t) * 64 * NIN), (LAS unsigned*)(lds + (buf) * 32768 + 16384 + (2 * wid + _i) * 1024), 16, 0, 0); } } while (0)
    float m_run = -INFINITY, l_run = 0.f;
    f32x16 o[4];
#pragma unroll
    for (int d0 = 0; d0 < 4; ++d0) o[d0] = f32x16{};
    const int qabs = q0 + wq * 32 + r32;
    ATT_DMA(0, 0);
    for (int t = 0; t < NT; ++t) {
        __syncthreads();
        if (t + 1 < NT) ATT_DMA(t + 1, (t + 1) & 1);
        if (64 * t <= q0 + wq * 32 + 31) {
            const LAS unsigned char* Kb = lds + (t & 1) * 32768 + map * 8192 + hi * 1024 + r32 * 16;
            const LAS unsigned char* Vb = lds + (t & 1) * 32768 + 16384 + ((lane >> 4) & 1) * 32 + (lane & 3) * 8 + (4 * hi + ((lane & 15) >> 2)) * 64;
            f32x16 p0 = f32x16{}, p1 = f32x16{};
#pragma unroll
            for (int d0 = 0; d0 < 4; ++d0) {
                const bf16x8 k0 = *(const LAS bf16x8*)(Kb + d0 * 2048), k1 = *(const LAS bf16x8*)(Kb + d0 * 2048 + 512);
                p0 = __builtin_amdgcn_mfma_f32_32x32x16_bf16(k0, qr[d0], p0, 0, 0, 0);
                p1 = __builtin_amdgcn_mfma_f32_32x32x16_bf16(k1, qr[d0], p1, 0, 0, 0);
            }
            if (t >= NT - 2) {
#pragma unroll
                for (int r = 0; r < 16; ++r) { const int kv = 64 * t + crow(r, hi); if (kv > qabs) p0[r] = -INFINITY; if (kv + 32 > qabs) p1[r] = -INFINITY; }
            }
            float rm = fmaxf(p0[0], p1[0]);
#pragma unroll
            for (int r = 1; r < 16; ++r) rm = fmaxf(rm, fmaxf(p0[r], p1[r]));
            { auto rr = __builtin_amdgcn_permlane32_swap(__float_as_uint(rm), __float_as_uint(rm), false, false); rm = fmaxf(__uint_as_float(rr[0]), __uint_as_float(rr[1])); }
            const float mnew = fmaxf(m_run, rm);
            const float f = __builtin_amdgcn_exp2f(m_run - mnew);
            m_run = mnew;
            float ls = 0.f;
#pragma unroll
            for (int r = 0; r < 16; ++r) { p0[r] = __builtin_amdgcn_exp2f(p0[r] - mnew); p1[r] = __builtin_amdgcn_exp2f(p1[r] - mnew); ls += p0[r] + p1[r]; }
            l_run = l_run * f + ls;
            if (!__all(f == 1.0f)) {
#pragma unroll
                for (int d0 = 0; d0 < 4; ++d0)
#pragma unroll
                    for (int r = 0; r < 16; ++r) o[d0][r] *= f;
            }
            bf16x8 pa[4];
#pragma unroll
            for (int s = 0; s < 2; ++s) {
                u32x4 w0, w1;
                w0.x = pk2(p0[8 * s + 0], p0[8 * s + 1]); w0.y = pk2(p0[8 * s + 2], p0[8 * s + 3]); w0.z = pk2(p0[8 * s + 4], p0[8 * s + 5]); w0.w = pk2(p0[8 * s + 6], p0[8 * s + 7]);
                w1.x = pk2(p1[8 * s + 0], p1[8 * s + 1]); w1.y = pk2(p1[8 * s + 2], p1[8 * s + 3]); w1.z = pk2(p1[8 * s + 4], p1[8 * s + 5]); w1.w = pk2(p1[8 * s + 6], p1[8 * s + 7]);
                pa[s] = __builtin_bit_cast(bf16x8, w0); pa[2 + s] = __builtin_bit_cast(bf16x8, w1);
            }
#pragma unroll
            for (int d0 = 0; d0 < 4; ++d0) {
#pragma unroll
                for (int ks = 0; ks < 4; ++ks) {
                    const s16x4 lo = vtr(Vb + (d0 * 4 + ks) * 1024), hh = vtr(Vb + (d0 * 4 + ks) * 1024 + 512);
                    const bf16x8 vf = (bf16x8){lo[0], lo[1], lo[2], lo[3], hh[0], hh[1], hh[2], hh[3]};
                    o[d0] = __builtin_amdgcn_mfma_f32_32x32x16_bf16(vf, pa[ks], o[d0], 0, 0, 0);
                }
            }
        }
    }
#undef ATT_DMA
    { auto rr = __builtin_amdgcn_permlane32_swap(__float_as_uint(l_run), __float_as_uint(l_run), false, false); l_run = __uint_as_float(rr[0]) + __uint_as_float(rr[1]); }
    const float rl = 1.0f / l_run;
    __syncthreads();
    LAS float* xs = (LAS float*)lds + wq * 4096 + lane;
    if (map == 1) {
#pragma unroll
        for (int d0 = 0; d0 < 4; ++d0)
#pragma unroll
            for (int r = 0; r < 16; ++r) xs[(d0 * 16 + r) * 64] = o[d0][r] * rl;
    }
    __syncthreads();
    if (map == 0) {
        float ss = 0.f;
#pragma unroll
        for (int d0 = 0; d0 < 4; ++d0)
#pragma unroll
            for (int r = 0; r < 16; ++r) { const float a = o[d0][r] * rl - lam * xs[(d0 * 16 + r) * 64]; o[d0][r] = a; ss += a * a; }
        { auto rr = __builtin_amdgcn_permlane32_swap(__float_as_uint(ss), __float_as_uint(ss), false, false); ss = __uint_as_float(rr[0]) + __uint_as_float(rr[1]); }
        const float rs = rsqrtf(ss * (1.0f / 128.0f) + RMS_EPS) * (1.0f - LAMBDA_INIT);
        bf16_t* Op = MIX + (size_t)(rowbase + qabs) * D + h * 128 + 4 * hi;
#pragma unroll
        for (int d0 = 0; d0 < 4; ++d0)
#pragma unroll
            for (int g = 0; g < 4; ++g) { const int dv = d0 * 32 + 8 * g + 4 * hi; const f32x4 sg = *(const f32x4*)(subln_g + dv);
                u32x2 w; w.x = pk2(o[d0][4 * g + 0] * rs * sg[0], o[d0][4 * g + 1] * rs * sg[1]); w.y = pk2(o[d0][4 * g + 2] * rs * sg[2], o[d0][4 * g + 3] * rs * sg[3]);
                *(u32x2*)(Op + d0 * 32 + 8 * g) = w; }
    }
    __syncthreads();
}
}

__device__ __forceinline__ void pool_unit(int tile, int g, const bf16_t* QKVU, const bf16_t* WPt, const float* b_pool, const float* pool_scale, bf16_t* MIX, LAS unsigned char* lds) {
    const int tid = threadIdx.x, lane = tid & 63, fr = lane & 15, fq = lane >> 4; const int wid = __builtin_amdgcn_readfirstlane(tid >> 6);
    const int t0 = tile * 128, s0 = t0 % SEQ, w = 2 << g;
    LAS float* U = (LAS float*)lds;
    LAS bf16_t* Z = (LAS bf16_t*)(lds + 144 * 132 * 4);
    for (int it = tid; it < 144 * 16; it += 512) { const int r = it >> 4, c8 = (it & 15) * 8; const int trow = t0 - 16 + r;
        f32x4 lo = {0.f, 0.f, 0.f, 0.f}, hi4 = {0.f, 0.f, 0.f, 0.f};
        if (s0 + r - 16 >= 0) { const u32x4 v = *(const u32x4*)(QKVU + (size_t)trow * NIN + 1536 + g * 128 + c8);
            lo = (f32x4){__uint_as_float(v.x << 16), __uint_as_float(v.x & 0xffff0000u), __uint_as_float(v.y << 16), __uint_as_float(v.y & 0xffff0000u)};
            hi4 = (f32x4){__uint_as_float(v.z << 16), __uint_as_float(v.z & 0xffff0000u), __uint_as_float(v.w << 16), __uint_as_float(v.w & 0xffff0000u)}; }
        *(LAS f32x4*)(U + r * 132 + c8) = lo; *(LAS f32x4*)(U + r * 132 + c8 + 4) = hi4; }
    __syncthreads();
    for (int it = tid; it < 128 * 64; it += 512) { const int r = it >> 6, c2 = (it & 63) * 2; float a0 = 0.f, a1 = 0.f;
        for (int j = 0; j < w; ++j) { const f32x2 v = *(const LAS f32x2*)(U + (16 + r - j) * 132 + c2); a0 += v.x; a1 += v.y; }
        const int pos1 = s0 + r + 1; const float inv = 1.0f / (float)(pos1 < w ? pos1 : w); const f32x2 uu = *(const LAS f32x2*)(U + (16 + r) * 132 + c2);
        *(LAS unsigned*)(Z + r * 136 + c2) = pk2(a0 * inv - uu.x, a1 * inv - uu.y); }
    __syncthreads();
    f32x4 acc[8];
#pragma unroll
    for (int nb = 0; nb < 8; ++nb) acc[nb] = (f32x4){0.f, 0.f, 0.f, 0.f};
#pragma unroll
    for (int ks = 0; ks < 4; ++ks) { const bf16x8 zf = *(const LAS bf16x8*)(Z + (wid * 16 + fr) * 136 + ks * 32 + fq * 8);
#pragma unroll
        for (int nb = 0; nb < 8; ++nb) { const bf16x8 wf = *(const bf16x8*)(WPt + (size_t)g * 16384 + (nb * 16 + fr) * 128 + ks * 32 + fq * 8); acc[nb] = __builtin_amdgcn_mfma_f32_16x16x32_bf16(wf, zf, acc[nb], 0, 0, 0); } }
    bf16_t* Op = MIX + (size_t)(t0 + wid * 16 + fr) * D + 512 + g * 128;
#pragma unroll
    for (int nb = 0; nb < 8; ++nb) { const int c = nb * 16 + 4 * fq; const f32x4 bb = *(const f32x4*)(b_pool + g * 128 + c), ps = *(const f32x4*)(pool_scale + g * 128 + c); const f32x4 v = (acc[nb] + bb) * ps;
        u32x2 wv; wv.x = pk2(v[0], v[1]); wv.y = pk2(v[2], v[3]); *(u32x2*)(Op + c) = wv; }
    __syncthreads();
}

__device__ __forceinline__ void transpose_item(const float* W, int N, int k0, int n0, bf16_t* WT, int K, int drow0, LAS float* scr, int lane) {
#pragma unroll 8
    for (int i = 0; i < 32; ++i) { const int kk = 2 * i + (lane >> 5); scr[kk * 33 + (lane & 31)] = W[(size_t)(k0 + kk) * N + n0 + (lane & 31)]; }
    asm volatile("s_waitcnt lgkmcnt(0)" ::: "memory");
    const int c = lane & 7;
#pragma unroll
    for (int j = 0; j < 4; ++j) { const int n = (lane >> 3) + 8 * j; const LAS float* s = scr + (8 * c) * 33 + n;
        u32x4 o; o.x = pk2(s[0 * 33], s[1 * 33]); o.y = pk2(s[2 * 33], s[3 * 33]); o.z = pk2(s[4 * 33], s[5 * 33]); o.w = pk2(s[6 * 33], s[7 * 33]);
        *(u32x4*)(WT + (size_t)(drow0 + n) * K + k0 + 8 * c) = o; }
    asm volatile("s_waitcnt lgkmcnt(0)" ::: "memory");
}
__device__ __forceinline__ void rms_row_to_bf16(const float* xrow, const float* g, bf16_t* orow, int lane) {
    const f32x4* xr = (const f32x4*)xrow + lane; const f32x4* gr = (const f32x4*)g + lane;
    f32x4 v[4]; float s = 0.f;
#pragma unroll
    for (int j = 0; j < 4; ++j) { v[j] = xr[64 * j]; s += (v[j].x * v[j].x + v[j].y * v[j].y) + (v[j].z * v[j].z + v[j].w * v[j].w); }
    const float rstd = rsqrtf(wave_sum(s) * (1.f / D) + RMS_EPS);
    u32x2* o8 = (u32x2*)orow + lane;
#pragma unroll
    for (int j = 0; j < 4; ++j) { const f32x4 gg = gr[64 * j]; u32x2 w; w.x = pk2(v[j].x * rstd * gg.x, v[j].y * rstd * gg.y); w.y = pk2(v[j].z * rstd * gg.z, v[j].w * rstd * gg.w); o8[64 * j] = w; }
}

struct Args {
    const float *x, *norm1_g, *w_in, *lq1, *lk1, *lq2, *lk2, *subln_g, *w_pool, *b_pool, *pool_scale, *w_out, *norm2_g, *router_w, *router_b,
                *w_gate, *b_gate, *w_up, *b_up, *w_down, *b_down, *final_g;
    float* out; unsigned char* ws; int ph_lo, ph_hi;
};

__global__ void __launch_bounds__(512, 2) mk_fwd(Args a) {
    extern __shared__ __attribute__((aligned(16))) unsigned char lds_raw[];
    LAS unsigned char* lds = (LAS unsigned char*)lds_raw;
    const int tid = threadIdx.x, lane = tid & 63; const int wave = __builtin_amdgcn_readfirstlane(tid >> 6);
    const int G = gridDim.x, bx = blockIdx.x; const int vcu = (G % 8 == 0) ? (bx % 8) * (G / 8) + bx / 8 : bx;
    unsigned char* ws = a.ws;
    unsigned* ctl = (unsigned*)(ws + WS_CTL);
    bf16_t* WIN = (bf16_t*)(ws + WS_WIN); bf16_t* WOUT = (bf16_t*)(ws + WS_WOUT); bf16_t* WPOOL = (bf16_t*)(ws + WS_WPOOL);
    bf16_t* WD = (bf16_t*)(ws + WS_WD); bf16_t* WGU = (bf16_t*)(ws + WS_WGU); bf16_t* ACT = (bf16_t*)(ws + WS_ACT);
    bf16_t* XN = (bf16_t*)(ws + WS_XN); bf16_t* QKVU = (bf16_t*)(ws + WS_QKVU); bf16_t* MIX = (bf16_t*)(ws + WS_MIX); bf16_t* Y = (bf16_t*)(ws + WS_Y);
    int* TOKE = (int*)(ws + WS_TOKE); int* TOKP = (int*)(ws + WS_TOKP); int* LTOK = (int*)(ws + WS_LTOK); float* LGATE = (float*)(ws + WS_LGATE);
    float* x1 = a.out;
    LAS int* ldsx = (LAS int*)(lds + LDSX_OFF);
    const int lo = a.ph_lo, hi = a.ph_hi;
#define IN(k) (lo <= (k) && (k) < hi)
#if MK_N_LAUNCHES == 1
#define GRID_BAR() do { cg::this_grid().sync(); } while (0)
#else
#define GRID_BAR() do { } while (0)
#endif
    const int gw = vcu * 8 + wave, NGW = G * 8;

    if (IN(0)) {
        LAS float* scr = (LAS float*)(lds + wave * 16384);
        constexpr int I_EXP = 96 * 512, I_IN = 16 * 64, I_OUT = 512, I_POOL = 32, NITEMS = I_EXP + I_IN + I_OUT + I_POOL;
        for (int it = gw; it < NITEMS; it += NGW) {
            int r = it;
            if (r < I_EXP) { const int mi = r >> 9, e = mi / 3, which = mi % 3, q = r & 511, kb = q >> 5, nb = q & 31, n0 = nb * 32;
                if (which == 2) transpose_item(a.w_down + (size_t)e * D * D, D, kb * 64, n0, WD + (size_t)e * D * D, D, n0, scr, lane);
                else transpose_item((which == 0 ? a.w_gate : a.w_up) + (size_t)e * D * D, D, kb * 64, n0, WGU + (size_t)e * 2048 * D, D, (n0 >> 7) * 256 + which * 128 + (n0 & 127), scr, lane);
                continue; }
            r -= I_EXP;
            if (r < I_IN) { const int kb = r >> 6, nb = r & 63; transpose_item(a.w_in, NIN, kb * 64, nb * 32, WIN, D, nb * 32, scr, lane); continue; }
            r -= I_IN;
            if (r < I_OUT) { const int kb = r >> 5, nb = r & 31; transpose_item(a.w_out, D, kb * 64, nb * 32, WOUT, D, nb * 32, scr, lane); continue; }
            r -= I_OUT;
            { const int g = r >> 3, q = r & 7, kb = q >> 2, nb = q & 3; transpose_item(a.w_pool + (size_t)g * 16384, 128, kb * 64, nb * 32, WPOOL + (size_t)g * 16384, 128, nb * 32, scr, lane); }
        }
        for (int m = gw; m < M; m += NGW) rms_row_to_bf16(a.x + (size_t)m * D, a.norm1_g, XN + (size_t)m * D, lane);
        if (IN(1)) GRID_BAR();
    }

    if (IN(1)) {
        pg8::DenseSched S; S.init(M, NIN, D, G, bx, WIN);
        pg8::EpiQkvu E{QKVU};
        pg8::gemm_phase<pg8::EpiQkvu, pg8::DenseSched, true>(lds, (const char*)XN, D, S, E);
        if (IN(2)) GRID_BAR();
    }

    if (IN(2)) {
        float s1 = 0.f, s2 = 0.f;
        for (int i = 0; i < 64; ++i) { s1 += a.lq1[i] * a.lk1[i]; s2 += a.lq2[i] * a.lk2[i]; }
        const float lam = __expf(s1) - __expf(s2) + LAMBDA_INIT;
        for (int p = vcu; p < 256; p += G) { const int bh = p >> 3, j = p & 7;
            att::attn_unit(bh >> 2, bh & 3, 15 - j, QKVU, MIX, lds, lam, a.subln_g);
            att::attn_unit(bh >> 2, bh & 3, j, QKVU, MIX, lds, lam, a.subln_g); }
        for (int u = vcu; u < 512; u += G) pool_unit(u >> 2, u & 3, QKVU, WPOOL, a.b_pool, a.pool_scale, MIX, lds);
        if (IN(3)) GRID_BAR();
    }

    if (IN(3)) {
        pg8::DenseSched S; S.init(M, D, D, G, bx, WOUT);
        pg8::EpiResF32 E{a.x, x1};
        pg8::gemm_phase<pg8::EpiResF32, pg8::DenseSched, true>(lds, (const char*)MIX, D, S, E);
        if (IN(4)) GRID_BAR();
    }

    if (IN(4)) {
        for (int it = tid; it < 1024 * 8; it += 512) { const int c = it >> 3, ch = it & 7; const f32x4 v = *(const f32x4*)(a.router_w + (size_t)c * NE + ch * 4);
            *(LAS f32x4*)(lds + c * 128 + ((ch ^ ((c >> 1) & 7)) * 16)) = v; }
        if (tid < 32) ldsx[128 + tid] = 0;
        __syncthreads();
        LAS int* pend = (LAS int*)(lds + LDSX_OFF + 1024);
        int nloc = 0;
        for (int m = gw; m < M; m += NGW, ++nloc) {
            float hv[16]; float ss = 0.f;
#pragma unroll
            for (int i = 0; i < 16; ++i) { hv[i] = x1[(size_t)m * D + lane + 64 * i]; ss += hv[i] * hv[i]; }
            const float rstd = rsqrtf(wave_sum(ss) * (1.f / D) + RMS_EPS);
#pragma unroll
            for (int i = 0; i < 16; ++i) { hv[i] = hv[i] * rstd * a.norm2_g[lane + 64 * i]; }
#pragma unroll
            for (int i = 0; i < 16; ++i) XN[(size_t)m * D + lane + 64 * i] = (bf16_t)(pk2(hv[i], 0.f) & 0xffffu);
            float lg[32];
#pragma unroll
            for (int e = 0; e < 32; ++e) lg[e] = 0.f;
#pragma unroll
            for (int i = 0; i < 16; ++i) { const int c = lane + 64 * i; const LAS unsigned char* rp = lds + c * 128; const int sw = (c >> 1) & 7;
#pragma unroll
                for (int ch = 0; ch < 8; ++ch) { const f32x4 w = *(const LAS f32x4*)(rp + ((ch ^ sw) * 16));
                    lg[ch * 4 + 0] += hv[i] * w.x; lg[ch * 4 + 1] += hv[i] * w.y; lg[ch * 4 + 2] += hv[i] * w.z; lg[ch * 4 + 3] += hv[i] * w.w; } }
            float v16[16];
#pragma unroll
            for (int e = 0; e < 16; ++e) { const float mine = (lane & 32) ? lg[e + 16] : lg[e], oth = (lane & 32) ? lg[e] : lg[e + 16]; v16[e] = mine + __shfl_xor(oth, 32); }
            float v8[8];
#pragma unroll
            for (int e = 0; e < 8; ++e) { const float mine = (lane & 16) ? v16[e + 8] : v16[e], oth = (lane & 16) ? v16[e] : v16[e + 8]; v8[e] = mine + __shfl_xor(oth, 16); }
            float v4[4];
#pragma unroll
            for (int e = 0; e < 4; ++e) { const float mine = (lane & 8) ? v8[e + 4] : v8[e], oth = (lane & 8) ? v8[e] : v8[e + 4]; v4[e] = mine + __shfl_xor(oth, 8); }
            float v2[2];
#pragma unroll
            for (int e = 0; e < 2; ++e) { const float mine = (lane & 4) ? v4[e + 2] : v4[e], oth = (lane & 4) ? v4[e] : v4[e + 2]; v2[e] = mine + __shfl_xor(oth, 4); }
            float v1; { const float mine = (lane & 2) ? v2[1] : v2[0], oth = (lane & 2) ? v2[0] : v2[1]; v1 = mine + __shfl_xor(oth, 2); }
            v1 += __shfl_xor(v1, 1);
            const int myexp = ((lane >> 5) & 1) * 16 + ((lane >> 4) & 1) * 8 + ((lane >> 3) & 1) * 4 + ((lane >> 2) & 1) * 2 + ((lane >> 1) & 1);
            float logit = v1 + a.router_b[myexp];
            int es[4]; float vs[4];
#pragma unroll
            for (int k = 0; k < 4; ++k) { const float mx = wave_max(logit); const int cand = (logit == mx) ? myexp : 99; const int em = wave_min_i(cand); es[k] = em; vs[k] = mx; if (myexp == em) logit = -INFINITY; }
            const float e1 = __expf(vs[1] - vs[0]), e2 = __expf(vs[2] - vs[0]), e3 = __expf(vs[3] - vs[0]); const float inv = 1.0f / (1.0f + e1 + e2 + e3);
            const float gs[4] = {inv, e1 * inv, e2 * inv, e3 * inv};
            if (lane < 4) { const int k = lane; const int e = k == 0 ? es[0] : k == 1 ? es[1] : k == 2 ? es[2] : es[3]; const float gt = k == 0 ? gs[0] : k == 1 ? gs[1] : k == 2 ? gs[2] : gs[3];
                const int rank = __hip_atomic_fetch_add((LAS int*)(ldsx + 128 + e), 1, __ATOMIC_RELAXED, __HIP_MEMORY_SCOPE_WORKGROUP);
                LAS int* pe = pend + ((wave * 8 + nloc) * 4 + k) * 4; pe[0] = e; pe[1] = rank; pe[2] = __float_as_int(gt); pe[3] = m; }
        }
        if (lane == 0) ldsx[224 + wave] = nloc;
        __syncthreads();
        if (tid < 32) ldsx[192 + tid] = (int)atomicAdd(ctl + CW_CNT + tid, (unsigned)ldsx[128 + tid]);
        __syncthreads();
        if (tid < 256) { const int w8 = tid >> 5, rem = tid & 31, nl = rem >> 2, k = rem & 3;
            if (nl < ldsx[224 + w8]) { LAS int* pe = pend + ((w8 * 8 + nl) * 4 + k) * 4; const int e = pe[0], pos = ldsx[192 + e] + pe[1], m = pe[3];
                LTOK[(size_t)e * M + pos] = m; LGATE[(size_t)e * M + pos] = __int_as_float(pe[2]); TOKE[m * 4 + k] = e; TOKP[m * 4 + k] = pos; } }
        if (IN(5)) GRID_BAR();
    }

    if (IN(5) || IN(6) || IN(7)) {
        __syncthreads();
        if (tid < 32) ldsx[64 + tid] = (int)__hip_atomic_load(ctl + CW_CNT + tid, __ATOMIC_RELAXED, __HIP_MEMORY_SCOPE_AGENT);
        __syncthreads();
        if (tid == 0) { int acc = 0; for (int e = 0; e < NE; ++e) { ldsx[e] = acc; acc += (ldsx[64 + e] + 255) >> 8; } ldsx[NE] = acc; }
        __syncthreads();
    }

    if (IN(5)) {
        pg8::MoeSched S{ldsx, ldsx + 64, 8, vcu / (G / 8), vcu % (G / 8), D, (const char*)WGU, (size_t)2048 * D * 2, LTOK, true};
        pg8::EpiSwiglu E{ACT, a.b_gate, a.b_up};
        pg8::gemm_phase<pg8::EpiSwiglu, pg8::MoeSched, true>(lds, (const char*)XN, D, S, E);
        if (IN(6)) GRID_BAR();
    }

    if (IN(6)) {
        pg8::MoeSched S{ldsx, ldsx + 64, 4, vcu / (G / 8), vcu % (G / 8), DFF, (const char*)WD, (size_t)D * DFF * 2, LTOK, false};
        pg8::EpiDown E{Y, a.b_down, LGATE, ldsx};
        pg8::gemm_phase<pg8::EpiDown, pg8::MoeSched, true>(lds, (const char*)ACT, DFF, S, E);
        if (IN(7)) GRID_BAR();
    }

    if (IN(7)) {
        for (int m = gw; m < M; m += NGW) {
            const bf16_t* yr[4];
#pragma unroll
            for (int k = 0; k < 4; ++k) { const int e = TOKE[m * 4 + k], pos = TOKP[m * 4 + k]; yr[k] = Y + ((size_t)ldsx[e] * 256 + pos) * D; }
            f32x4 v[4]; float ss = 0.f;
#pragma unroll
            for (int j = 0; j < 4; ++j) { v[j] = *((const f32x4*)(x1 + (size_t)m * D) + lane + 64 * j);
#pragma unroll
                for (int k = 0; k < 4; ++k) { const u32x2 yv = *((const u32x2*)yr[k] + lane + 64 * j);
                    v[j].x += __uint_as_float(yv.x << 16); v[j].y += __uint_as_float(yv.x & 0xffff0000u); v[j].z += __uint_as_float(yv.y << 16); v[j].w += __uint_as_float(yv.y & 0xffff0000u); }
                ss += (v[j].x * v[j].x + v[j].y * v[j].y) + (v[j].z * v[j].z + v[j].w * v[j].w); }
            const float rstd = rsqrtf(wave_sum(ss) * (1.f / D) + RMS_EPS);
#pragma unroll
            for (int j = 0; j < 4; ++j) { const f32x4 gg = *((const f32x4*)a.final_g + lane + 64 * j); *((f32x4*)(a.out + (size_t)m * D) + lane + 64 * j) = v[j] * rstd * gg; }
        }
    }
#undef IN
#undef GRID_BAR
}

extern "C" void kernel_launch(void* const* d_in, const int* in_sizes, int n_in, void* d_out, int out_size, void* d_ws, size_t ws_size, hipStream_t stream) {
    static int grid = 0;
    if (grid == 0) {
        if (n_in != 22 || in_sizes[0] != M * D || out_size != M * D || ws_size < WS_END) { fprintf(stderr, "kernel_launch: unexpected shapes / workspace (n_in %d, ws %zu)\n", n_in, ws_size); grid = -1; return; }
        int dev = 0, cus = 0, per_cu = 0;
        (void)hipGetDevice(&dev); (void)hipDeviceGetAttribute(&cus, hipDeviceAttributeMultiprocessorCount, dev);
        (void)hipFuncSetAttribute((const void*)mk_fwd, hipFuncAttributeMaxDynamicSharedMemorySize, LDS_BYTES);
        (void)hipOccupancyMaxActiveBlocksPerMultiprocessor(&per_cu, (const void*)mk_fwd, 512, LDS_BYTES);
        (void)hipGetLastError();
        if (per_cu < 1) { fprintf(stderr, "kernel_launch: occupancy query says %d blocks per CU\n", per_cu); grid = -1; return; }
        grid = cus;
        if (grid % 8 != 0) grid -= grid % 8;
    }
    if (grid < 0) return;
    (void)hipMemsetAsync((char*)d_ws + WS_CTL, 0, CTL_ZERO_BYTES, stream);
    Args a{};
    const float** f = (const float**)&a;
    for (int i = 0; i < 22; ++i) f[i] = (const float*)d_in[i];
    a.out = (float*)d_out; a.ws = (unsigned char*)d_ws;
#if MK_N_LAUNCHES == 1
    a.ph_lo = 0; a.ph_hi = 8;
    void* args[] = {&a};
    hipError_t e = hipLaunchCooperativeKernel((const void*)mk_fwd, dim3(grid), dim3(512), args, LDS_BYTES, stream);
    if (e != hipSuccess) fprintf(stderr, "cooperative launch failed: %s (grid %d)\n", hipGetErrorString(e), grid);
#else
    for (int p = 0; p < 8; ++p) { a.ph_lo = p; a.ph_hi = p + 1; hipLaunchKernelGGL(mk_fwd, dim3(grid), dim3(512), LDS_BYTES, stream, a); }
#endif
}
```

```cpp
#include <hip/hip_runtime.h>
#include <hip/hip_cooperative_groups.h>
#include <cstdio>
#include <cstdint>
namespace cg = cooperative_groups;

#ifndef MK_N_LAUNCHES
#define MK_N_LAUNCHES 1
#endif

#define LAS __attribute__((address_space(3)))
#define GAS __attribute__((address_space(1)))
typedef unsigned short bf16_t;
typedef short bf16x8 __attribute__((ext_vector_type(8)));
typedef short s16x4 __attribute__((ext_vector_type(4)));
typedef float f32x4 __attribute__((ext_vector_type(4)));
typedef float f32x2 __attribute__((ext_vector_type(2)));
typedef float f32x16 __attribute__((ext_vector_type(16)));
typedef unsigned u32x4 __attribute__((ext_vector_type(4)));
typedef unsigned u32x2 __attribute__((ext_vector_type(2)));
typedef __bf16 bf16x2_t __attribute__((ext_vector_type(2)));

constexpr int BATCH = 8, SEQ = 2048, D = 1024, M = BATCH * SEQ;
constexpr int NIN = 2048;
constexpr int NE = 32, TOPK = 4, DFF = 1024;
constexpr int NSLOT = M * TOPK;
constexpr int PADROWS = NSLOT + NE * 256;
constexpr float RMS_EPS = 1e-5f;
constexpr float QSCALE = 0.125f * 1.4426950408889634f;
constexpr float LAMBDA_INIT = 0.2f;

constexpr size_t MiB = 1u << 20;
constexpr size_t WS_CTL = 0, CTL_ZERO_BYTES = 1 * MiB;
constexpr size_t WS_WIN = 1 * MiB;
constexpr size_t WS_WOUT = 5 * MiB;
constexpr size_t WS_WPOOL = 7 * MiB;
constexpr size_t WS_TOKE = 8 * MiB;
constexpr size_t WS_TOKP = WS_TOKE + 256 * 1024;
constexpr size_t WS_LTOK = 9 * MiB;
constexpr size_t WS_LGATE = 11 * MiB;
constexpr size_t WS_WD = 16 * MiB;
constexpr size_t WS_WGU = 80 * MiB;
constexpr size_t WS_ACT = 208 * MiB;
constexpr size_t WS_XN = 352 * MiB;
constexpr size_t WS_QKVU = 384 * MiB;
constexpr size_t WS_MIX = 448 * MiB;
constexpr size_t WS_Y = 352 * MiB;
constexpr size_t WS_END = 496 * MiB;
constexpr int CW_CNT = 64;
constexpr int CW_BAR = 4096;

constexpr int RING_BYTES = 131072;
constexpr int LDSX_OFF = RING_BYTES;
constexpr int LDS_BYTES = 147456;

__device__ __forceinline__ unsigned pk2(float lo, float hi) { f32x2 v = {lo, hi}; bf16x2_t b = __builtin_convertvector(v, bf16x2_t); return __builtin_bit_cast(unsigned, b); }
__device__ __forceinline__ float bf2f(unsigned short h) { return __uint_as_float(((unsigned)h) << 16); }
__device__ __forceinline__ float wave_sum(float v) {
#pragma unroll
    for (int o = 1; o < 64; o <<= 1) v += __shfl_xor(v, o);
    return v;
}
__device__ __forceinline__ float wave_max(float v) {
#pragma unroll
    for (int o = 1; o < 64; o <<= 1) v = fmaxf(v, __shfl_xor(v, o));
    return v;
}
__device__ __forceinline__ int wave_min_i(int v) {
#pragma unroll
    for (int o = 1; o < 64; o <<= 1) { int w = __shfl_xor(v, o); v = w < v ? w : v; }
    return v;
}

namespace pg8 {
constexpr int BM = 256, BK = 64, HALF = 128, HTB = HALF * BK * 2, STAGE_BYTES = 8 * HTB;
__device__ __forceinline__ int lds_byte(int r, int c) { const int st = (r >> 4) * 2 + (c >> 5), rr = r & 15, cc = c & 31, ob = rr * 64 + cc * 2; return st * 1024 + (ob ^ (((ob >> 9) & 1) << 5)); }
__device__ __forceinline__ void stage_rc(int b, int& R, int& C) { const int st = b / 1024, sb = b % 1024, swz = sb ^ (((sb >> 9) & 1) << 5); R = (st >> 1) * 16 + swz / 64; C = (st & 1) * 32 + (swz % 64) / 2; }
__device__ __forceinline__ int perm32(int rho) { const int n = rho >> 4, i = rho & 15; return 8 * (i >> 2) + 4 * n + (i & 3); }

struct Unit { int pm, pn, e; unsigned a00, a01, a10, a11; const char* B; };

template <class Epi, class Sched, bool ALIGN_EPI>
__device__ __forceinline__ void gemm_phase(LAS unsigned char* lds, const char* A, const int K, const Sched& S, const Epi& E) {
    const int tid = threadIdx.x, wid = __builtin_amdgcn_readfirstlane(tid >> 6), lane = tid & 63, wr = wid >> 2, wc = wid & 3, fr = lane & 15, fq = lane >> 4;
    const int nt = K / BK;
    int R0, C0, R1, C1; stage_rc(tid * 16, R0, C0); stage_rc(tid * 16 + 8192, R1, C1);
    unsigned voffB[2];
    { const int Rb0 = Epi::PERM ? ((R0 & ~31) + perm32(R0 & 31)) : R0, Rb1 = Epi::PERM ? ((R1 & ~31) + perm32(R1 & 31)) : R1;
      voffB[0] = (unsigned)(Rb0 * K + C0) * 2u; voffB[1] = (unsigned)(Rb1 * K + C1) * 2u; }
    const size_t kstep = (size_t)(BK * 2);
    const size_t hstep = (size_t)HALF * K * 2;
    const unsigned ldsw = (unsigned)wid * 1024u;
    const int aoff = lds_byte(wr * 64 + fr, fq * 8), boff = lds_byte(wc * 32 + fr, fq * 8);
#define PG8_SA(b, h) (((b) * 2 + (h)) * HTB)
#define PG8_SB(b, h) ((4 + (b) * 2 + (h)) * HTB)
#define PG8_STAGEB(bufoff, gbase) do { _Pragma("unroll") for (int _i = 0; _i < 2; ++_i) \
        __builtin_amdgcn_global_load_lds((const unsigned*)((const char*)(gbase) + voffB[_i]), (LAS unsigned*)(lds + (bufoff) + ldsw + _i * 8192), 16, 0, 0); } while (0)
#define PG8_STAGEA(bufoff, kb, o0, o1) do { \
        __builtin_amdgcn_global_load_lds((const unsigned*)(A + (size_t)(o0) + (kb)), (LAS unsigned*)(lds + (bufoff) + ldsw), 16, 0, 0); \
        __builtin_amdgcn_global_load_lds((const unsigned*)(A + (size_t)(o1) + (kb)), (LAS unsigned*)(lds + (bufoff) + ldsw + 8192), 16, 0, 0); } while (0)
#define PG8_LDA(dst, b, h) do { _Pragma("unroll") for (int m = 0; m < 4; ++m) _Pragma("unroll") for (int k = 0; k < 2; ++k) dst[m][k] = *(const LAS bf16x8*)(lds + PG8_SA(b, h) + aoff + m * 2048 + k * 1024); } while (0)
#define PG8_LDB(dst, b, h) do { _Pragma("unroll") for (int n = 0; n < 2; ++n) _Pragma("unroll") for (int k = 0; k < 2; ++k) dst[n][k] = *(const LAS bf16x8*)(lds + PG8_SB(b, h) + boff + n * 2048 + k * 1024); } while (0)
#define PG8_MMA(ai, bj, At, Bt) do { __builtin_amdgcn_s_setprio(1); _Pragma("unroll") for (int m = 0; m < 4; ++m) _Pragma("unroll") for (int n = 0; n < 2; ++n) _Pragma("unroll") for (int k = 0; k < 2; ++k) \
        acc[ai][bj][m][n] = __builtin_amdgcn_mfma_f32_16x16x32_bf16(Bt[n][k], At[m][k], acc[ai][bj][m][n], 0, 0, 0); __builtin_amdgcn_s_setprio(0); } while (0)
#define PG8_WAIT_V(n) asm volatile("s_waitcnt vmcnt(" #n ")" ::: "memory")
#define PG8_WAIT_L(n) asm volatile("s_waitcnt lgkmcnt(" #n ")" ::: "memory")
#define PG8_BAR __builtin_amdgcn_s_barrier()
#define PG8_SCHED __builtin_amdgcn_sched_barrier(0)
    Unit cur, nxt; int ui = 0;
    if (!S.next(0, cur, R0, C0, R1, C1)) return;
    f32x4 acc[2][2][4][2];
#pragma unroll
    for (int a = 0; a < 2; ++a)
#pragma unroll
        for (int b = 0; b < 2; ++b)
#pragma unroll
            for (int m = 0; m < 4; ++m)
#pragma unroll
                for (int n = 0; n < 2; ++n) acc[a][b][m][n] = (f32x4){0.f, 0.f, 0.f, 0.f};
    bf16x8 At[4][2], B0[2][2], B1[2][2];
    const char* cB = cur.B;
    PG8_STAGEB(PG8_SB(0, 0), cB); PG8_STAGEB(PG8_SB(0, 1), cB + hstep); PG8_STAGEA(PG8_SA(0, 0), 0, cur.a00, cur.a01); PG8_STAGEA(PG8_SA(0, 1), 0, cur.a10, cur.a11);
    if (wr == 1) PG8_BAR;
    PG8_WAIT_V(2); PG8_BAR;
    PG8_STAGEB(PG8_SB(1, 0), cB + kstep); PG8_STAGEA(PG8_SA(1, 0), kstep, cur.a00, cur.a01); PG8_STAGEB(PG8_SB(1, 1), cB + hstep + kstep);
    PG8_WAIT_V(6); PG8_BAR;
    for (;;) {
        const bool has_next = S.next(ui + 1, nxt, R0, C0, R1, C1);
        if (!has_next) nxt = cur;
        const char* nB = nxt.B;
        for (int t = 0; t < nt; t += 2) {
            const bool last = (t == nt - 2);
            const size_t k1 = (size_t)(t + 1) * kstep;
            const size_t k2 = last ? 0 : (size_t)(t + 2) * kstep, k3 = k2 + kstep;
            const char* b2 = last ? nB : cB + (size_t)(t + 2) * kstep; const char* b3 = b2 + kstep;
            const unsigned s00 = last ? nxt.a00 : cur.a00, s01 = last ? nxt.a01 : cur.a01, s10 = last ? nxt.a10 : cur.a10, s11 = last ? nxt.a11 : cur.a11;
            PG8_LDB(B0, 0, 0); PG8_LDB(B1, 0, 1); PG8_SCHED; PG8_LDA(At, 0, 0); PG8_STAGEA(PG8_SA(1, 1), k1, cur.a10, cur.a11);
            PG8_WAIT_V(8); PG8_WAIT_L(0); PG8_BAR; PG8_MMA(0, 0, At, B0); PG8_MMA(0, 1, At, B1); PG8_BAR; PG8_SCHED;
            PG8_LDA(At, 0, 1); PG8_STAGEB(PG8_SB(0, 0), b2); PG8_STAGEB(PG8_SB(0, 1), b2 + hstep); PG8_STAGEA(PG8_SA(0, 0), k2, s00, s01);
            PG8_WAIT_V(8); PG8_WAIT_L(0); PG8_BAR; PG8_MMA(1, 0, At, B0); PG8_MMA(1, 1, At, B1); PG8_BAR; PG8_SCHED;
            PG8_LDB(B0, 1, 0); PG8_LDB(B1, 1, 1); PG8_SCHED; PG8_LDA(At, 1, 0); PG8_STAGEA(PG8_SA(0, 1), k2, s10, s11);
            PG8_WAIT_V(8); PG8_WAIT_L(0); PG8_BAR; PG8_MMA(0, 0, At, B0); PG8_MMA(0, 1, At, B1); PG8_BAR; PG8_SCHED;
            PG8_LDA(At, 1, 1); PG8_STAGEB(PG8_SB(1, 0), b3); PG8_STAGEB(PG8_SB(1, 1), b3 + hstep); PG8_STAGEA(PG8_SA(1, 0), k3, s00, s01);
            PG8_WAIT_V(8); PG8_WAIT_L(0); PG8_BAR; PG8_MMA(1, 0, At, B0); PG8_MMA(1, 1, At, B1); PG8_BAR; PG8_SCHED;
        }
        if constexpr (ALIGN_EPI) { if (wr == 0) PG8_BAR; }
        E(acc, cur, wr, wc, fr, fq);
        if (!has_next) break;
#pragma unroll
        for (int a = 0; a < 2; ++a)
#pragma unroll
            for (int b = 0; b < 2; ++b)
#pragma unroll
                for (int m = 0; m < 4; ++m)
#pragma unroll
                    for (int n = 0; n < 2; ++n) acc[a][b][m][n] = (f32x4){0.f, 0.f, 0.f, 0.f};
        cur = nxt; cB = nB; ++ui;
        if constexpr (ALIGN_EPI) { if (wr == 1) PG8_BAR; }
    }
    PG8_WAIT_V(0);
    if constexpr (!ALIGN_EPI) { if (wr == 0) PG8_BAR; }
    PG8_BAR;
#undef PG8_SA
#undef PG8_SB
#undef PG8_STAGEA
#undef PG8_STAGEB
#undef PG8_LDA
#undef PG8_LDB
#undef PG8_MMA
#undef PG8_WAIT_V
#undef PG8_WAIT_L
#undef PG8_BAR
#undef PG8_SCHED
}

struct DenseSched {
    int nM, nN, nwg, G, c, K; const char* Bt;
    __device__ __forceinline__ void init(int Mr, int N, int K_, int G_, int c_, const void* Bt_) { nM = Mr / BM; nN = N / BM; nwg = nM * nN; G = G_; c = c_; K = K_; Bt = (const char*)Bt_; }
    __device__ __forceinline__ bool next(int i, Unit& u, int R0, int C0, int R1, int C1) const {
        const long L = (long)i * G + c; if (L >= nwg) return false;
        int wgid = (int)L; { const int q = nwg / 8, r = nwg % 8, xcd = wgid % 8, off = wgid / 8; wgid = (xcd < r ? xcd * (q + 1) : r * (q + 1) + (xcd - r) * q) + off; }
        const int WGM = 8, nig = WGM * nN, gid = wgid / nig, fm = gid * WGM, gsz = (nM - fm) < WGM ? (nM - fm) : WGM;
        u.pm = fm + ((wgid % nig) % gsz); u.pn = (wgid % nig) / gsz; u.e = 0;
        const unsigned rb = (unsigned)u.pm * 256u;
        u.a00 = ((rb + R0) * K + C0) * 2u; u.a01 = ((rb + R1) * K + C1) * 2u; u.a10 = ((rb + 128 + R0) * K + C0) * 2u; u.a11 = ((rb + 128 + R1) * K + C1) * 2u;
        u.B = Bt + (size_t)u.pn * 256 * K * 2; return true;
    }
};
struct MoeSched {
    const LAS int* tp; const LAS int* cnt; int NT; int xcd, j; int K; const char* W; size_t wstride; const int* ltok; bool gather;
    __device__ __forceinline__ bool next(int i, Unit& u, int R0, int C0, int R1, int C1) const {
        const int U = tp[NE] * NT; const int lo = (int)(((long)xcd * U) / 8), hi = (int)(((long)(xcd + 1) * U) / 8);
        const int L = lo + i * 32 + j; if (L >= hi) return false;
        int e = 0;
        for (int q = 1; q < NE; ++q) e = (L >= tp[q] * NT) ? q : e;
        const int nte = tp[e + 1] - tp[e], r = L - tp[e] * NT, pn = r / nte, mt = r % nte;
        u.e = e; u.pn = pn; u.pm = tp[e] + mt;
        if (gather) {
            const int ce = cnt[e]; const int* lt = ltok + (size_t)e * M;
            const int i00 = mt * 256 + R0, i01 = mt * 256 + R1, i10 = i00 + 128, i11 = i01 + 128;
            const unsigned t00 = i00 < ce ? (unsigned)lt[i00] : 0u, t01 = i01 < ce ? (unsigned)lt[i01] : 0u, t10 = i10 < ce ? (unsigned)lt[i10] : 0u, t11 = i11 < ce ? (unsigned)lt[i11] : 0u;
            u.a00 = (t00 * K + C0) * 2u; u.a01 = (t01 * K + C1) * 2u; u.a10 = (t10 * K + C0) * 2u; u.a11 = (t11 * K + C1) * 2u;
        } else {
            const unsigned rb = (unsigned)u.pm * 256u;
            u.a00 = ((rb + R0) * K + C0) * 2u; u.a01 = ((rb + R1) * K + C1) * 2u; u.a10 = ((rb + 128 + R0) * K + C0) * 2u; u.a11 = ((rb + 128 + R1) * K + C1) * 2u;
        }
        u.B = W + (size_t)e * wstride + (size_t)pn * 256 * K * 2; return true;
    }
};

struct EpiQkvu {
    static constexpr bool PERM = true; bf16_t* O;
    __device__ __forceinline__ void operator()(const f32x4 (&acc)[2][2][4][2], const Unit& u, int wr, int wc, int fr, int fq) const {
        const int row0 = u.pm * BM + wr * 64 + fr, col0 = u.pn * BM + wc * 32 + 8 * fq; const float sc = (u.pn < 2) ? QSCALE : 1.f;
#pragma unroll
        for (int ai = 0; ai < 2; ++ai)
#pragma unroll
            for (int m = 0; m < 4; ++m) { bf16_t* rowp = O + (size_t)(row0 + ai * HALF + m * 16) * NIN + col0;
#pragma unroll
                for (int bj = 0; bj < 2; ++bj) { const f32x4 v0 = acc[ai][bj][m][0] * sc, v1 = acc[ai][bj][m][1] * sc;
                    u32x4 w; w.x = pk2(v0[0], v0[1]); w.y = pk2(v0[2], v0[3]); w.z = pk2(v1[0], v1[1]); w.w = pk2(v1[2], v1[3]);
                    *(u32x4*)(rowp + bj * HALF) = w; } }
    }
};
struct EpiResF32 {
    static constexpr bool PERM = false; const float* base; float* out;
    __device__ __forceinline__ void operator()(const f32x4 (&acc)[2][2][4][2], const Unit& u, int wr, int wc, int fr, int fq) const {
        const int col0 = u.pn * BM + wc * 32 + 4 * fq;
#pragma unroll
        for (int ai = 0; ai < 2; ++ai)
#pragma unroll
            for (int m = 0; m < 4; ++m) { const size_t off = (size_t)(u.pm * BM + ai * HALF + wr * 64 + m * 16 + fr) * D + col0;
#pragma unroll
                for (int bj = 0; bj < 2; ++bj)
#pragma unroll
                    for (int n = 0; n < 2; ++n) { const f32x4 bs = *(const f32x4*)(base + off + bj * HALF + n * 16); *(f32x4*)(out + off + bj * HALF + n * 16) = bs + acc[ai][bj][m][n]; } }
    }
};
struct EpiSwiglu {
    static constexpr bool PERM = true; bf16_t* ACT; const float* bg; const float* bu;
    __device__ __forceinline__ void operator()(const f32x4 (&acc)[2][2][4][2], const Unit& u, int wr, int wc, int fr, int fq) const {
        const int row0 = u.pm * BM + wr * 64 + fr, col0 = u.pn * 128 + wc * 32 + 8 * fq;
        f32x4 g4[2], u4[2];
#pragma unroll
        for (int n = 0; n < 2; ++n) { g4[n] = *(const f32x4*)(bg + (size_t)u.e * DFF + col0 + 4 * n); u4[n] = *(const f32x4*)(bu + (size_t)u.e * DFF + col0 + 4 * n); }
#pragma unroll
        for (int ai = 0; ai < 2; ++ai)
#pragma unroll
            for (int m = 0; m < 4; ++m) { float a[8];
#pragma unroll
                for (int n = 0; n < 2; ++n)
#pragma unroll
                    for (int j = 0; j < 4; ++j) { const float g = fminf(acc[ai][0][m][n][j] + g4[n][j], 7.0f); const float up = fminf(fmaxf(acc[ai][1][m][n][j] + u4[n][j], -7.0f), 7.0f);
                        const float sg = __builtin_amdgcn_rcpf(1.0f + __builtin_amdgcn_exp2f(-1.702f * 1.4426950408889634f * g)); a[n * 4 + j] = g * sg * (up + 1.0f); }
                u32x4 w; w.x = pk2(a[0], a[1]); w.y = pk2(a[2], a[3]); w.z = pk2(a[4], a[5]); w.w = pk2(a[6], a[7]);
                *(u32x4*)(ACT + (size_t)(row0 + ai * HALF + m * 16) * DFF + col0) = w; }
    }
};
struct EpiDown {
    static constexpr bool PERM = true; bf16_t* Y; const float* bd; const float* lgate; const LAS int* tp;
    __device__ __forceinline__ void operator()(const f32x4 (&acc)[2][2][4][2], const Unit& u, int wr, int wc, int fr, int fq) const {
        const int mt = u.pm - tp[u.e]; const int row0 = u.pm * BM + wr * 64 + fr, col0 = u.pn * BM + wc * 32 + 8 * fq;
        const float* lg = lgate + (size_t)u.e * M + mt * 256 + wr * 64 + fr;
        f32x4 bv[2][2];
#pragma unroll
        for (int bj = 0; bj < 2; ++bj)
#pragma unroll
            for (int n = 0; n < 2; ++n) bv[bj][n] = *(const f32x4*)(bd + (size_t)u.e * D + col0 + bj * HALF + 4 * n);
#pragma unroll
        for (int ai = 0; ai < 2; ++ai)
#pragma unroll
            for (int m = 0; m < 4; ++m) { const float gt = lg[ai * HALF + m * 16]; bf16_t* rowp = Y + (size_t)(row0 + ai * HALF + m * 16) * D + col0;
#pragma unroll
                for (int bj = 0; bj < 2; ++bj) { const f32x4 v0 = (acc[ai][bj][m][0] + bv[bj][0]) * gt, v1 = (acc[ai][bj][m][1] + bv[bj][1]) * gt;
                    u32x4 w; w.x = pk2(v0[0], v0[1]); w.y = pk2(v0[2], v0[3]); w.z = pk2(v1[0], v1[1]); w.w = pk2(v1[2], v1[3]);
                    *(u32x4*)(rowp + bj * HALF) = w; } }
    }
};
}

namespace att {
__device__ __forceinline__ int crow(int r, int hi) { return (r & 3) + 8 * (r >> 2) + 4 * hi; }
__device__ __forceinline__ s16x4 vtr(const LAS unsigned char* p) { typedef short v4 __attribute__((ext_vector_type(4))); return __builtin_bit_cast(s16x4, __builtin_amdgcn_ds_read_tr16_b64_v4i16((LAS v4*)p)); }

__device__ __forceinline__ void attn_unit(int b, int h, int qb, const bf16_t* QKVU, bf16_t* MIX, LAS unsigned char* lds, float lam, const float* subln_g) {
    const int tid = threadIdx.x, lane = tid & 63, r32 = lane & 31, hi = lane >> 5; const int wid = __builtin_amdgcn_readfirstlane(tid >> 6);
    const int map = wid >> 2, wq = wid & 3;
    const long rowbase = (long)b * SEQ; const int q0 = qb * 128;
    const int NT = 2 * qb + 2;
    const bf16_t* Qp = QKVU + (size_t)(rowbase + q0 + wq * 32 + r32) * NIN + h * 128 + map * 64 + hi * 8;
    bf16x8 qr[4];
#pragma unroll
    for (int d0 = 0; d0 < 4; ++d0) qr[d0] = *(const bf16x8*)(Qp + d0 * 16);
    const bf16_t* ksrc[2]; const bf16_t* vsrc[2];
#pragma unroll
    for (int i = 0; i < 2; ++i) { const int p = 2 * wid + i;
        ksrc[i] = QKVU + (size_t)(rowbase + lane) * NIN + 512 + h * 128 + (p >> 3) * 64 + (p & 7) * 8;
        vsrc[i] = QKVU + (size_t)(rowbase + 16 * (p & 3) + (lane >> 2)) * NIN + 1024 + h * 128 + (p >> 2) * 32 + (lane & 3) * 8; }
#define ATT_DMA(t, buf) do { _Pragma("unroll") for (int _i = 0; _i < 2; ++_i) { \
        __builtin_amdgcn_global_load_lds((const unsigned*)(ksrc[_i] + (size_t)(t) * 64 * NIN), (LAS unsigned*)(lds + (buf) * 32768 + (2 * wid + _i) * 1024), 16, 0, 0); \
        __builtin_amdgcn_global_load_lds((const unsigned*)(vsrc[_i] + (size_t)(t) * 64 * NIN), (LAS unsigned*)(lds + (buf) * 32768 + 16384 + (2 * wid + _i) * 1024), 16, 0, 0); } } while (0)
    float m_run = -INFINITY, l_run = 0.f;
    f32x16 o[4];
#pragma unroll
    for (int d0 = 0; d0 < 4; ++d0) o[d0] = f32x16{};
    const int qabs = q0 + wq * 32 + r32;
    ATT_DMA(0, 0);
    for (int t = 0; t < NT; ++t) {
        __syncthreads();
        if (t + 1 < NT) ATT_DMA(t + 1, (t + 1) & 1);
        if (64 * t <= q0 + wq * 32 + 31) {
            const LAS unsigned char* Kb = lds + (t & 1) * 32768 + map * 8192 + hi * 1024 + r32 * 16;
            const LAS unsigned char* Vb = lds + (t & 1) * 32768 + 16384 + ((lane >> 4) & 1) * 32 + (lane & 3) * 8 + (4 * hi + ((lane & 15) >> 2)) * 64;
            f32x16 p0 = f32x16{}, p1 = f32x16{};
#pragma unroll
            for (int d0 = 0; d0 < 4; ++d0) {
                const bf16x8 k0 = *(const LAS bf16x8*)(Kb + d0 * 2048), k1 = *(const LAS bf16x8*)(Kb + d0 * 2048 + 512);
                p0 = __builtin_amdgcn_mfma_f32_32x32x16_bf16(k0, qr[d0], p0, 0, 0, 0);
                p1 = __builtin_amdgcn_mfma_f32_32x32x16_bf16(k1, qr[d0], p1, 0, 0, 0);
            }
            if (t >= NT - 2) {
#pragma unroll
                for (int r = 0; r < 16; ++r) { const int kv = 64 * t + crow(r, hi); if (kv > qabs) p0[r] = -INFINITY; if (kv + 32 > qabs) p1[r] = -INFINITY; }
            }
            float rm = fmaxf(p0[0], p1[0]);
#pragma unroll
            for (int r = 1; r < 16; ++r) rm = fmaxf(rm, fmaxf(p0[r], p1[r]));
            { auto rr = __builtin_amdgcn_permlane32_swap(__float_as_uint(rm), __float_as_uint(rm), false, false); rm = fmaxf(__uint_as_float(rr[0]), __uint_as_float(rr[1])); }
            const float mnew = fmaxf(m_run, rm);
            const float f = __builtin_amdgcn_exp2f(m_run - mnew);
            m_run = mnew;
            float ls = 0.f;
#pragma unroll
            for (int r = 0; r < 16; ++r) { p0[r] = __builtin_amdgcn_exp2f(p0[r] - mnew); p1[r] = __builtin_amdgcn_exp2f(p1[r] - mnew); ls += p0[r] + p1[r]; }
            l_run = l_run * f + ls;
            if (!__all(f == 1.0f)) {
#pragma unroll
                for (int d0 = 0; d0 < 4; ++d0)
#pragma unroll
                    for (int r = 0; r < 16; ++r) o[d0][r] *= f;
            }
            bf16x8 pa[4];
#pragma unroll
            for (int s = 0; s < 2; ++s) {
                u32x4 w0, w1;
                w0.x = pk2(p0[8 * s + 0], p0[8 * s + 1]); w0.y = pk2(p0[8 * s + 2], p0[8 * s + 3]); w0.z = pk2(p0[8 * s + 4], p0[8 * s + 5]); w0.w = pk2(p0[8 * s + 6], p0[8 * s + 7]);
                w1.x = pk2(p1[8 * s + 0], p1[8 * s + 1]); w1.y = pk2(p1[8 * s + 2], p1[8 * s + 3]); w1.z = pk2(p1[8 * s + 4], p1[8 * s + 5]); w1.w = pk2(p1[8 * s + 6], p1[8 * s + 7]);
                pa[s] = __builtin_bit_cast(bf16x8, w0); pa[2 + s] = __builtin_bit_cast(bf16x8, w1);
            }
#pragma unroll
            for (int d0 = 0; d0 < 4; ++d0) {
#pragma unroll
                for (int ks = 0; ks < 4; ++ks) {
                    const s16x4 lo = vtr(Vb + (d0 * 4 + ks) * 1024), hh = vtr(Vb + (d0 * 4 + ks) * 1024 + 512);
                    const bf16x8 vf = (bf16x8){lo[0], lo[1], lo[2], lo[3], hh[0], hh[1], hh[2], hh[3]};
                    o[d0] = __builtin_amdgcn_mfma_f32_32x32x16_bf16(vf, pa[ks], o[d0], 0, 0, 0);
                }
            }
        }
    }
#undef ATT_DMA
    { auto rr = __builtin_amdgcn_permlane32_swap(__float_as_uint(l_run), __float_as_uint(l_run), false, false); l_run = __uint_as_float(rr[0]) + __uint_as_float(rr[1]); }
    const float rl = 1.0f / l_run;
    __syncthreads();
    LAS float* xs = (LAS float*)lds + wq * 4096 + lane;
    if (map == 1) {
#pragma unroll
        for (int d0 = 0; d0 < 4; ++d0)
#pragma unroll
            for (int r = 0; r < 16; ++r) xs[(d0 * 16 + r) * 64] = o[d0][r] * rl;
    }
    __syncthreads();
    if (map == 0) {
        float ss = 0.f;
#pragma unroll
        for (int d0 = 0; d0 < 4; ++d0)
#pragma unroll
            for (int r = 0; r < 16; ++r) { const float a = o[d0][r] * rl - lam * xs[(d0 * 16 + r) * 64]; o[d0][r] = a; ss += a * a; }
        { auto rr = __builtin_amdgcn_permlane32_swap(__float_as_uint(ss), __float_as_uint(ss), false, false); ss = __uint_as_float(rr[0]) + __uint_as_float(rr[1]); }
        const float rs = rsqrtf(ss * (1.0f / 128.0f) + RMS_EPS) * (1.0f - LAMBDA_INIT);
        bf16_t* Op = MIX + (size_t)(rowbase + qabs) * D + h * 128 + 4 * hi;
#pragma unroll
        for (int d0 = 0; d0 < 4; ++d0)
#pragma unroll
            for (int g = 0; g < 4; ++g) { const int dv = d0 * 32 + 8 * g + 4 * hi; const f32x4 sg = *(const f32x4*)(subln_g + dv);
                u32x2 w; w.x = pk2(o[d0][4 * g + 0] * rs * sg[0], o[d0][4 * g + 1] * rs * sg[1]); w.y = pk2(o[d0][4 * g + 2] * rs * sg[2], o[d0][4 * g + 3] * rs * sg[3]);
                *(u32x2*)(Op + d0 * 32 + 8 * g) = w; }
    }
    __syncthreads();
}
}

__device__ __forceinline__ void pool_unit(int tile, int g, const bf16_t* QKVU, const bf16_t* WPt, const float* b_pool, const float* pool_scale, bf16_t* MIX, LAS unsigned char* lds) {
    const int tid = threadIdx.x, lane = tid & 63, fr = lane & 15, fq = lane >> 4; const int wid = __builtin_amdgcn_readfirstlane(tid >> 6);
    const int t0 = tile * 128, s0 = t0 % SEQ, w = 2 << g;
    LAS float* U = (LAS float*)lds;
    LAS bf16_t* Z = (LAS bf16_t*)(lds + 144 * 132 * 4);
    for (int it = tid; it < 144 * 16; it += 512) { const int r = it >> 4, c8 = (it & 15) * 8; const int trow = t0 - 16 + r;
        f32x4 lo = {0.f, 0.f, 0.f, 0.f}, hi4 = {0.f, 0.f, 0.f, 0.f};
        if (s0 + r - 16 >= 0) { const u32x4 v = *(const u32x4*)(QKVU + (size_t)trow * NIN + 1536 + g * 128 + c8);
            lo = (f32x4){__uint_as_float(v.x << 16), __uint_as_float(v.x & 0xffff0000u), __uint_as_float(v.y << 16), __uint_as_float(v.y & 0xffff0000u)};
            hi4 = (f32x4){__uint_as_float(v.z << 16), __uint_as_float(v.z & 0xffff0000u), __uint_as_float(v.w << 16), __uint_as_float(v.w & 0xffff0000u)}; }
        *(LAS f32x4*)(U + r * 132 + c8) = lo; *(LAS f32x4*)(U + r * 132 + c8 + 4) = hi4; }
    __syncthreads();
    for (int it = tid; it < 128 * 64; it += 512) { const int r = it >> 6, c2 = (it & 63) * 2; float a0 = 0.f, a1 = 0.f;
        for (int j = 0; j < w; ++j) { const f32x2 v = *(const LAS f32x2*)(U + (16 + r - j) * 132 + c2); a0 += v.x; a1 += v.y; }
        const int pos1 = s0 + r + 1; const float inv = 1.0f / (float)(pos1 < w ? pos1 : w); const f32x2 uu = *(const LAS f32x2*)(U + (16 + r) * 132 + c2);
        *(LAS unsigned*)(Z + r * 136 + c2) = pk2(a0 * inv - uu.x, a1 * inv - uu.y); }
    __syncthreads();
    f32x4 acc[8];
#pragma unroll
    for (int nb = 0; nb < 8; ++nb) acc[nb] = (f32x4){0.f, 0.f, 0.f, 0.f};
#pragma unroll
    for (int ks = 0; ks < 4; ++ks) { const bf16x8 zf = *(const LAS bf16x8*)(Z + (wid * 16 + fr) * 136 + ks * 32 + fq * 8);
#pragma unroll
        for (int nb = 0; nb < 8; ++nb) { const bf16x8 wf = *(const bf16x8*)(WPt + (size_t)g * 16384 + (nb * 16 + fr) * 128 + ks * 32 + fq * 8); acc[nb] = __builtin_amdgcn_mfma_f32_16x16x32_bf16(wf, zf, acc[nb], 0, 0, 0); } }
    bf16_t* Op = MIX + (size_t)(t0 + wid * 16 + fr) * D + 512 + g * 128;
#pragma unroll
    for (int nb = 0; nb < 8; ++nb) { const int c = nb * 16 + 4 * fq; const f32x4 bb = *(const f32x4*)(b_pool + g * 128 + c), ps = *(const f32x4*)(pool_scale + g * 128 + c); const f32x4 v = (acc[nb] + bb) * ps;
        u32x2 wv; wv.x = pk2(v[0], v[1]); wv.y = pk2(v[2], v[3]); *(u32x2*)(Op + c) = wv; }
    __syncthreads();
}

__device__ __forceinline__ void transpose_item(const float* W, int N, int k0, int n0, bf16_t* WT, int K, int drow0, LAS float* scr, int lane) {
#pragma unroll 8
    for (int i = 0; i < 32; ++i) { const int kk = 2 * i + (lane >> 5); scr[kk * 33 + (lane & 31)] = W[(size_t)(k0 + kk) * N + n0 + (lane & 31)]; }
    asm volatile("s_waitcnt lgkmcnt(0)" ::: "memory");
    const int c = lane & 7;
#pragma unroll
    for (int j = 0; j < 4; ++j) { const int n = (lane >> 3) + 8 * j; const LAS float* s = scr + (8 * c) * 33 + n;
        u32x4 o; o.x = pk2(s[0 * 33], s[1 * 33]); o.y = pk2(s[2 * 33], s[3 * 33]); o.z = pk2(s[4 * 33], s[5 * 33]); o.w = pk2(s[6 * 33], s[7 * 33]);
        *(u32x4*)(WT + (size_t)(drow0 + n) * K + k0 + 8 * c) = o; }
    asm volatile("s_waitcnt lgkmcnt(0)" ::: "memory");
}
__device__ __forceinline__ void rms_row_to_bf16(const float* xrow, const float* g, bf16_t* orow, int lane) {
    const f32x4* xr = (const f32x4*)xrow + lane; const f32x4* gr = (const f32x4*)g + lane;
    f32x4 v[4]; float s = 0.f;
#pragma unroll
    for (int j = 0; j < 4; ++j) { v[j] = xr[64 * j]; s += (v[j].x * v[j].x + v[j].y * v[j].y) + (v[j].z * v[j].z + v[j].w * v[j].w); }
    const float rstd = rsqrtf(wave_sum(s) * (1.f / D) + RMS_EPS);
    u32x2* o8 = (u32x2*)orow + lane;
#pragma unroll
    for (int j = 0; j < 4; ++j) { const f32x4 gg = gr[64 * j]; u32x2 w; w.x = pk2(v[j].x * rstd * gg.x, v[j].y * rstd * gg.y); w.y = pk2(v[j].z * rstd * gg.z, v[j].w * rstd * gg.w); o8[64 * j] = w; }
}


#define XB_TMO      128
#define XB_XCNT(j)  (256  + 64 * (j))
#define XB_XSUB(j)  (1280 + 64 * (j))
#define XB_XGEN(j)  (2304 + 64 * (j))
#define XB_TOP      3328
#define XB_TOPGEN   3392
#define XCD_BAR_WORDS 3456
#define XB_SPIN_CAP (1u << 18)
__device__ __forceinline__ unsigned xb_ld(unsigned* p)              { return __hip_atomic_load(p, __ATOMIC_RELAXED, __HIP_MEMORY_SCOPE_AGENT); }
__device__ __forceinline__ unsigned xb_add(unsigned* p, unsigned v) { return __hip_atomic_fetch_add(p, v, __ATOMIC_RELAXED, __HIP_MEMORY_SCOPE_AGENT); }
__device__ __forceinline__ unsigned xb_xcc_id() { return (unsigned)__builtin_amdgcn_s_getreg((3 << 11) | 20) & 0xFu; }
#define XB_SPIN(cond, bar) do { unsigned _sp = 0; while (cond) { __builtin_amdgcn_s_sleep(1); \
    if ((++_sp & 255u) == 0u) { if (xb_ld(&(bar)[XB_TMO])) break; if (_sp > XB_SPIN_CAP) { atomicAdd(&(bar)[XB_TMO], 1u); break; } } } } while (0)
struct XcdBarrier { unsigned* bar; unsigned x; volatile LAS unsigned* st; };
__device__ __forceinline__ XcdBarrier xcd_barrier_post(unsigned* bar, volatile LAS unsigned* st) {
    XcdBarrier b; b.bar = bar; b.x = xb_xcc_id(); b.st = st;
    if (threadIdx.x == 0) (void)xb_add(&bar[XB_XCNT(b.x)], 1u);
    return b;
}
__device__ __forceinline__ void xcd_barrier_complete(unsigned* bar, unsigned x, unsigned& nloc, unsigned& nx) {
    const unsigned G = gridDim.x * gridDim.y * gridDim.z;
    unsigned sum, cnt, mine, sp = 0u;
    for (;;) {
        sum = 0u; cnt = 0u; mine = 0u;
#pragma unroll
        for (unsigned j = 0; j < 16; ++j) { const unsigned c = xb_ld(&bar[XB_XCNT(j)]); sum += c; cnt += (c > 0u) ? 1u : 0u; mine = (j == x) ? c : mine; }
        if (sum == G) break;
        __builtin_amdgcn_s_sleep(1);
        if ((++sp & 255u) == 0u) { if (xb_ld(&bar[XB_TMO])) break; if (sp > XB_SPIN_CAP) { atomicAdd(&bar[XB_TMO], 1u); break; } }
    }
    nloc = mine > 0u ? mine : 1u; nx = cnt > 0u ? cnt : 1u;
}
__device__ __forceinline__ void xcd_barrier(const XcdBarrier& b) {
    asm volatile("s_waitcnt vmcnt(0)" ::: "memory");
    __syncthreads();
    if (threadIdx.x == 0) {
        unsigned* bar = b.bar;
        __builtin_amdgcn_s_waitcnt(0);
        unsigned nloc = b.st[0], nx = b.st[1];
        if (nloc == 0u) { xcd_barrier_complete(bar, b.x, nloc, nx); b.st[0] = nloc; b.st[1] = nx; }
        const unsigned old = xb_add(&bar[XB_XSUB(b.x)], 1u);
        const unsigned gen = old / nloc;
        if (old + 1u == (gen + 1u) * nloc) {
            __builtin_amdgcn_fence(__ATOMIC_RELEASE, "agent");
            asm volatile("s_waitcnt vmcnt(0)" ::: "memory");
            const unsigned og = xb_add(&bar[XB_TOP], 1u);
            const unsigned tg = og / nx;
            if (og + 1u == (tg + 1u) * nx) xb_add(&bar[XB_TOPGEN], 1u);
            else XB_SPIN(xb_ld(&bar[XB_TOPGEN]) == tg, bar);
            __builtin_amdgcn_fence(__ATOMIC_ACQUIRE, "agent");
            xb_add(&bar[XB_XGEN(b.x)], 1u);
            asm volatile("s_waitcnt vmcnt(0)" ::: "memory");
        } else {
            XB_SPIN(xb_ld(&bar[XB_XGEN(b.x)]) == gen, bar);
            __builtin_amdgcn_fence(__ATOMIC_ACQUIRE, "agent");
            asm volatile("s_waitcnt vmcnt(0)" ::: "memory");
        }
    }
    __syncthreads();
}

struct Args {
    const float *x, *norm1_g, *w_in, *lq1, *lk1, *lq2, *lk2, *subln_g, *w_pool, *b_pool, *pool_scale, *w_out, *norm2_g, *router_w, *router_b,
                *w_gate, *b_gate, *w_up, *b_up, *w_down, *b_down, *final_g;
    float* out; unsigned char* ws; int ph_lo, ph_hi;
};

__global__ void __launch_bounds__(512, 2) mk_fwd(Args a) {
    extern __shared__ __attribute__((aligned(16))) unsigned char lds_raw[];
    LAS unsigned char* lds = (LAS unsigned char*)lds_raw;
    const int tid = threadIdx.x, lane = tid & 63; const int wave = __builtin_amdgcn_readfirstlane(tid >> 6);
    const int G = gridDim.x, bx = blockIdx.x; const int vcu = (G % 8 == 0) ? (bx % 8) * (G / 8) + bx / 8 : bx;
    unsigned char* ws = a.ws;
    unsigned* ctl = (unsigned*)(ws + WS_CTL);
    bf16_t* WIN = (bf16_t*)(ws + WS_WIN); bf16_t* WOUT = (bf16_t*)(ws + WS_WOUT); bf16_t* WPOOL = (bf16_t*)(ws + WS_WPOOL);
    bf16_t* WD = (bf16_t*)(ws + WS_WD); bf16_t* WGU = (bf16_t*)(ws + WS_WGU); bf16_t* ACT = (bf16_t*)(ws + WS_ACT);
    bf16_t* XN = (bf16_t*)(ws + WS_XN); bf16_t* QKVU = (bf16_t*)(ws + WS_QKVU); bf16_t* MIX = (bf16_t*)(ws + WS_MIX); bf16_t* Y = (bf16_t*)(ws + WS_Y);
    int* TOKE = (int*)(ws + WS_TOKE); int* TOKP = (int*)(ws + WS_TOKP); int* LTOK = (int*)(ws + WS_LTOK); float* LGATE = (float*)(ws + WS_LGATE);
    float* x1 = a.out;
    LAS int* ldsx = (LAS int*)(lds + LDSX_OFF);
    const int lo = a.ph_lo, hi = a.ph_hi;
#define IN(k) (lo <= (k) && (k) < hi)
#if MK_N_LAUNCHES == 1
    if (tid < 2) ldsx[248 + tid] = 0;
    __syncthreads();
    const XcdBarrier gbar = xcd_barrier_post(ctl + CW_BAR, (volatile LAS unsigned*)(ldsx + 248));
#define GRID_BAR() do { xcd_barrier(gbar); } while (0)
#else
#define GRID_BAR() do { } while (0)
#endif
    const int gw = vcu * 8 + wave, NGW = G * 8;

    if (IN(0)) {
        LAS float* scr = (LAS float*)(lds + wave * 16384);
        constexpr int I_EXP = 96 * 512, I_IN = 16 * 64, I_OUT = 512, I_POOL = 32, NITEMS = I_EXP + I_IN + I_OUT + I_POOL;
        for (int it = gw; it < NITEMS; it += NGW) {
            int r = it;
            if (r < I_EXP) { const int mi = r >> 9, e = mi / 3, which = mi % 3, q = r & 511, kb = q >> 5, nb = q & 31, n0 = nb * 32;
                if (which == 2) transpose_item(a.w_down + (size_t)e * D * D, D, kb * 64, n0, WD + (size_t)e * D * D, D, n0, scr, lane);
                else transpose_item((which == 0 ? a.w_gate : a.w_up) + (size_t)e * D * D, D, kb * 64, n0, WGU + (size_t)e * 2048 * D, D, (n0 >> 7) * 256 + which * 128 + (n0 & 127), scr, lane);
                continue; }
            r -= I_EXP;
            if (r < I_IN) { const int kb = r >> 6, nb = r & 63; transpose_item(a.w_in, NIN, kb * 64, nb * 32, WIN, D, nb * 32, scr, lane); continue; }
            r -= I_IN;
            if (r < I_OUT) { const int kb = r >> 5, nb = r & 31; transpose_item(a.w_out, D, kb * 64, nb * 32, WOUT, D, nb * 32, scr, lane); continue; }
            r -= I_OUT;
            { const int g = r >> 3, q = r & 7, kb = q >> 2, nb = q & 3; transpose_item(a.w_pool + (size_t)g * 16384, 128, kb * 64, nb * 32, WPOOL + (size_t)g * 16384, 128, nb * 32, scr, lane); }
        }
        for (int m = gw; m < M; m += NGW) rms_row_to_bf16(a.x + (size_t)m * D, a.norm1_g, XN + (size_t)m * D, lane);
        if (IN(1)) GRID_BAR();
    }

    if (IN(1)) {
        pg8::DenseSched S; S.init(M, NIN, D, G, bx, WIN);
        pg8::EpiQkvu E{QKVU};
        pg8::gemm_phase<pg8::EpiQkvu, pg8::DenseSched, true>(lds, (const char*)XN, D, S, E);
        if (IN(2)) GRID_BAR();
    }

    if (IN(2)) {
        float s1 = 0.f, s2 = 0.f;
        for (int i = 0; i < 64; ++i) { s1 += a.lq1[i] * a.lk1[i]; s2 += a.lq2[i] * a.lk2[i]; }
        const float lam = __expf(s1) - __expf(s2) + LAMBDA_INIT;
        for (int p = vcu; p < 256; p += G) { const int bh = p >> 3, j = p & 7;
            att::attn_unit(bh >> 2, bh & 3, 15 - j, QKVU, MIX, lds, lam, a.subln_g);
            att::attn_unit(bh >> 2, bh & 3, j, QKVU, MIX, lds, lam, a.subln_g); }
        for (int u = vcu; u < 512; u += G) pool_unit(u >> 2, u & 3, QKVU, WPOOL, a.b_pool, a.pool_scale, MIX, lds);
        if (IN(3)) GRID_BAR();
    }

    if (IN(3)) {
        pg8::DenseSched S; S.init(M, D, D, G, bx, WOUT);
        pg8::EpiResF32 E{a.x, x1};
        pg8::gemm_phase<pg8::EpiResF32, pg8::DenseSched, true>(lds, (const char*)MIX, D, S, E);
        if (IN(4)) GRID_BAR();
    }

    if (IN(4)) {
        for (int it = tid; it < 1024 * 8; it += 512) { const int c = it >> 3, ch = it & 7; const f32x4 v = *(const f32x4*)(a.router_w + (size_t)c * NE + ch * 4);
            *(LAS f32x4*)(lds + c * 128 + ((ch ^ ((c >> 1) & 7)) * 16)) = v; }
        if (tid < 32) ldsx[128 + tid] = 0;
        __syncthreads();
        LAS int* pend = (LAS int*)(lds + LDSX_OFF + 1024);
        int nloc = 0;
        for (int m = gw; m < M; m += NGW, ++nloc) {
            float hv[16]; float ss = 0.f;
#pragma unroll
            for (int i = 0; i < 16; ++i) { hv[i] = x1[(size_t)m * D + lane + 64 * i]; ss += hv[i] * hv[i]; }
            const float rstd = rsqrtf(wave_sum(ss) * (1.f / D) + RMS_EPS);
#pragma unroll
            for (int i = 0; i < 16; ++i) { hv[i] = hv[i] * rstd * a.norm2_g[lane + 64 * i]; }
#pragma unroll
            for (int i = 0; i < 16; ++i) XN[(size_t)m * D + lane + 64 * i] = (bf16_t)(pk2(hv[i], 0.f) & 0xffffu);
            float lg[32];
#pragma unroll
            for (int e = 0; e < 32; ++e) lg[e] = 0.f;
#pragma unroll
            for (int i = 0; i < 16; ++i) { const int c = lane + 64 * i; const LAS unsigned char* rp = lds + c * 128; const int sw = (c >> 1) & 7;
#pragma unroll
                for (int ch = 0; ch < 8; ++ch) { const f32x4 w = *(const LAS f32x4*)(rp + ((ch ^ sw) * 16));
                    lg[ch * 4 + 0] += hv[i] * w.x; lg[ch * 4 + 1] += hv[i] * w.y; lg[ch * 4 + 2] += hv[i] * w.z; lg[ch * 4 + 3] += hv[i] * w.w; } }
            float v16[16];
#pragma unroll
            for (int e = 0; e < 16; ++e) { const float mine = (lane & 32) ? lg[e + 16] : lg[e], oth = (lane & 32) ? lg[e] : lg[e + 16]; v16[e] = mine + __shfl_xor(oth, 32); }
            float v8[8];
#pragma unroll
            for (int e = 0; e < 8; ++e) { const float mine = (lane & 16) ? v16[e + 8] : v16[e], oth = (lane & 16) ? v16[e] : v16[e + 8]; v8[e] = mine + __shfl_xor(oth, 16); }
            float v4[4];
#pragma unroll
            for (int e = 0; e < 4; ++e) { const float mine = (lane & 8) ? v8[e + 4] : v8[e], oth = (lane & 8) ? v8[e] : v8[e + 4]; v4[e] = mine + __shfl_xor(oth, 8); }
            float v2[2];
#pragma unroll
            for (int e = 0; e < 2; ++e) { const float mine = (lane & 4) ? v4[e + 2] : v4[e], oth = (lane & 4) ? v4[e] : v4[e + 2]; v2[e] = mine + __shfl_xor(oth, 4); }
            float v1; { const float mine = (lane & 2) ? v2[1] : v2[0], oth = (lane & 2) ? v2[0] : v2[1]; v1 = mine + __shfl_xor(oth, 2); }
            v1 += __shfl_xor(v1, 1);
            const int myexp = ((lane >> 5) & 1) * 16 + ((lane >> 4) & 1) * 8 + ((lane >> 3) & 1) * 4 + ((lane >> 2) & 1) * 2 + ((lane >> 1) & 1);
            float logit = v1 + a.router_b[myexp];
            int es[4]; float vs[4];
#pragma unroll
            for (int k = 0; k < 4; ++k) { const float mx = wave_max(logit); const int cand = (logit == mx) ? myexp : 99; const int em = wave_min_i(cand); es[k] = em; vs[k] = mx; if (myexp == em) logit = -INFINITY; }
            const float e1 = __expf(vs[1] - vs[0]), e2 = __expf(vs[2] - vs[0]), e3 = __expf(vs[3] - vs[0]); const float inv = 1.0f / (1.0f + e1 + e2 + e3);
            const float gs[4] = {inv, e1 * inv, e2 * inv, e3 * inv};
            if (lane < 4) { const int k = lane; const int e = k == 0 ? es[0] : k == 1 ? es[1] : k == 2 ? es[2] : es[3]; const float gt = k == 0 ? gs[0] : k == 1 ? gs[1] : k == 2 ? gs[2] : gs[3];
                const int rank = __hip_atomic_fetch_add((LAS int*)(ldsx + 128 + e), 1, __ATOMIC_RELAXED, __HIP_MEMORY_SCOPE_WORKGROUP);
                LAS int* pe = pend + ((wave * 8 + nloc) * 4 + k) * 4; pe[0] = e; pe[1] = rank; pe[2] = __float_as_int(gt); pe[3] = m; }
        }
        if (lane == 0) ldsx[224 + wave] = nloc;
        __syncthreads();
        if (tid < 32) ldsx[192 + tid] = (int)atomicAdd(ctl + CW_CNT + tid, (unsigned)ldsx[128 + tid]);
        __syncthreads();
        if (tid < 256) { const int w8 = tid >> 5, rem = tid & 31, nl = rem >> 2, k = rem & 3;
            if (nl < ldsx[224 + w8]) { LAS int* pe = pend + ((w8 * 8 + nl) * 4 + k) * 4; const int e = pe[0], pos = ldsx[192 + e] + pe[1], m = pe[3];
                LTOK[(size_t)e * M + pos] = m; LGATE[(size_t)e * M + pos] = __int_as_float(pe[2]); TOKE[m * 4 + k] = e; TOKP[m * 4 + k] = pos; } }
        if (IN(5)) GRID_BAR();
    }

    if (IN(5) || IN(6) || IN(7)) {
        __syncthreads();
        if (tid < 32) ldsx[64 + tid] = (int)__hip_atomic_load(ctl + CW_CNT + tid, __ATOMIC_RELAXED, __HIP_MEMORY_SCOPE_AGENT);
        __syncthreads();
        if (tid == 0) { int acc = 0; for (int e = 0; e < NE; ++e) { ldsx[e] = acc; acc += (ldsx[64 + e] + 255) >> 8; } ldsx[NE] = acc; }
        __syncthreads();
    }

    if (IN(5)) {
        pg8::MoeSched S{ldsx, ldsx + 64, 8, vcu / (G / 8), vcu % (G / 8), D, (const char*)WGU, (size_t)2048 * D * 2, LTOK, true};
        pg8::EpiSwiglu E{ACT, a.b_gate, a.b_up};
        pg8::gemm_phase<pg8::EpiSwiglu, pg8::MoeSched, true>(lds, (const char*)XN, D, S, E);
        if (IN(6)) GRID_BAR();
    }

    if (IN(6)) {
        pg8::MoeSched S{ldsx, ldsx + 64, 4, vcu / (G / 8), vcu % (G / 8), DFF, (const char*)WD, (size_t)D * DFF * 2, LTOK, false};
        pg8::EpiDown E{Y, a.b_down, LGATE, ldsx};
        pg8::gemm_phase<pg8::EpiDown, pg8::MoeSched, true>(lds, (const char*)ACT, DFF, S, E);
        if (IN(7)) GRID_BAR();
    }

    if (IN(7)) {
        for (int m = gw; m < M; m += NGW) {
            const bf16_t* yr[4];
#pragma unroll
            for (int k = 0; k < 4; ++k) { const int e = TOKE[m * 4 + k], pos = TOKP[m * 4 + k]; yr[k] = Y + ((size_t)ldsx[e] * 256 + pos) * D; }
            f32x4 v[4]; float ss = 0.f;
#pragma unroll
            for (int j = 0; j < 4; ++j) { v[j] = *((const f32x4*)(x1 + (size_t)m * D) + lane + 64 * j);
#pragma unroll
                for (int k = 0; k < 4; ++k) { const u32x2 yv = *((const u32x2*)yr[k] + lane + 64 * j);
                    v[j].x += __uint_as_float(yv.x << 16); v[j].y += __uint_as_float(yv.x & 0xffff0000u); v[j].z += __uint_as_float(yv.y << 16); v[j].w += __uint_as_float(yv.y & 0xffff0000u); }
                ss += (v[j].x * v[j].x + v[j].y * v[j].y) + (v[j].z * v[j].z + v[j].w * v[j].w); }
            const float rstd = rsqrtf(wave_sum(ss) * (1.f / D) + RMS_EPS);
#pragma unroll
            for (int j = 0; j < 4; ++j) { const f32x4 gg = *((const f32x4*)a.final_g + lane + 64 * j); *((f32x4*)(a.out + (size_t)m * D) + lane + 64 * j) = v[j] * rstd * gg; }
        }
    }
#undef IN
#undef GRID_BAR
}

extern "C" void kernel_launch(void* const* d_in, const int* in_sizes, int n_in, void* d_out, int out_size, void* d_ws, size_t ws_size, hipStream_t stream) {
    static int grid = 0;
    if (grid == 0) {
        if (n_in != 22 || in_sizes[0] != M * D || out_size != M * D || ws_size < WS_END) { fprintf(stderr, "kernel_launch: unexpected shapes / workspace (n_in %d, ws %zu)\n", n_in, ws_size); grid = -1; return; }
        int dev = 0, cus = 0, per_cu = 0;
        (void)hipGetDevice(&dev); (void)hipDeviceGetAttribute(&cus, hipDeviceAttributeMultiprocessorCount, dev);
        (void)hipFuncSetAttribute((const void*)mk_fwd, hipFuncAttributeMaxDynamicSharedMemorySize, LDS_BYTES);
        (void)hipOccupancyMaxActiveBlocksPerMultiprocessor(&per_cu, (const void*)mk_fwd, 512, LDS_BYTES);
        (void)hipGetLastError();
        if (per_cu < 1) { fprintf(stderr, "kernel_launch: occupancy query says %d blocks per CU\n", per_cu); grid = -1; return; }
        grid = cus;
        if (grid % 8 != 0) grid -= grid % 8;
    }
    if (grid < 0) return;
    (void)hipMemsetAsync((char*)d_ws + WS_CTL, 0, CTL_ZERO_BYTES, stream);
    Args a{};
    const float** f = (const float**)&a;
    for (int i = 0; i < 22; ++i) f[i] = (const float*)d_in[i];
    a.out = (float*)d_out; a.ws = (unsigned char*)d_ws;
#if MK_N_LAUNCHES == 1
    a.ph_lo = 0; a.ph_hi = 8;
    void* args[] = {&a};
    hipError_t e = hipLaunchCooperativeKernel((const void*)mk_fwd, dim3(grid), dim3(512), args, LDS_BYTES, stream);
    if (e != hipSuccess) fprintf(stderr, "cooperative launch failed: %s (grid %d)\n", hipGetErrorString(e), grid);
#else
    for (int p = 0; p < 8; ++p) { a.ph_lo = p; a.ph_hi = p + 1; hipLaunchKernelGGL(mk_fwd, dim3(grid), dim3(512), LDS_BYTES, stream, a); }
#endif
}
```

```cpp
#include <hip/hip_runtime.h>
#include <hip/hip_cooperative_groups.h>
#include <cstdio>
#include <cstdint>
namespace cg = cooperative_groups;

#ifndef MK_N_LAUNCHES
#define MK_N_LAUNCHES 1
#endif

#ifndef REP0
#define REP0 1
#endif
#ifndef REP1
#define REP1 1
#endif
#ifndef REP2
#define REP2 1
#endif
#ifndef REP3
#define REP3 1
#endif
#ifndef REPPOOL
#define REPPOOL 1
#endif
#ifndef REP4
#define REP4 1
#endif
#ifndef REP7
#define REP7 1
#endif
#ifndef REP5
#define REP5 1
#endif
#ifndef REP6
#define REP6 1
#endif
#define LAS __attribute__((address_space(3)))
#define GAS __attribute__((address_space(1)))
typedef unsigned short bf16_t;
typedef short bf16x8 __attribute__((ext_vector_type(8)));
typedef short s16x4 __attribute__((ext_vector_type(4)));
typedef float f32x4 __attribute__((ext_vector_type(4)));
typedef float f32x2 __attribute__((ext_vector_type(2)));
typedef float f32x16 __attribute__((ext_vector_type(16)));
typedef unsigned u32x4 __attribute__((ext_vector_type(4)));
typedef unsigned u32x2 __attribute__((ext_vector_type(2)));
typedef __bf16 bf16x2_t __attribute__((ext_vector_type(2)));

constexpr int BATCH = 8, SEQ = 2048, D = 1024, M = BATCH * SEQ;
constexpr int NIN = 2048;
constexpr int NE = 32, TOPK = 4, DFF = 1024;
constexpr int NSLOT = M * TOPK;
constexpr int PADROWS = NSLOT + NE * 256;
constexpr float RMS_EPS = 1e-5f;
constexpr float QSCALE = 0.125f * 1.4426950408889634f;
constexpr float LAMBDA_INIT = 0.2f;

constexpr float W_SCALE = 64.0f, H_SCALE = 8.0f, ACT_SCALE = 4.0f;
constexpr float GU_DESCALE = 1.0f / (W_SCALE * H_SCALE), DN_DESCALE = 1.0f / (W_SCALE * ACT_SCALE);
constexpr size_t MiB = 1u << 20;
constexpr size_t WS_CTL = 0, CTL_ZERO_BYTES = 1 * MiB;
constexpr size_t WS_WIN = 1 * MiB;
constexpr size_t WS_WOUT = 5 * MiB;
constexpr size_t WS_WPOOL = 7 * MiB;
constexpr size_t WS_TOKE = 8 * MiB;
constexpr size_t WS_TOKP = WS_TOKE + 256 * 1024;
constexpr size_t WS_LTOK = 9 * MiB;
constexpr size_t WS_LGATE = 11 * MiB;
constexpr size_t WS_WD = 16 * MiB;
constexpr size_t WS_WGU = 80 * MiB;
constexpr size_t WS_ACT = 208 * MiB;
constexpr size_t WS_XN = 352 * MiB;
constexpr size_t WS_QKVU = 384 * MiB;
constexpr size_t WS_MIX = 448 * MiB;
constexpr size_t WS_Y = 352 * MiB;
constexpr size_t WS_END = 496 * MiB;
constexpr int CW_CNT = 64;
constexpr int CW_BAR = 4096;

constexpr int RING_BYTES = 131072;
constexpr int LDSX_OFF = RING_BYTES;
constexpr int LDS_BYTES = 147456;

__device__ __forceinline__ unsigned pk2(float lo, float hi) { f32x2 v = {lo, hi}; bf16x2_t b = __builtin_convertvector(v, bf16x2_t); return __builtin_bit_cast(unsigned, b); }
__device__ __forceinline__ unsigned pk4_fp8(float a, float b, float c, float d) { int w = 0; w = __builtin_amdgcn_cvt_pk_fp8_f32(a, b, w, false); w = __builtin_amdgcn_cvt_pk_fp8_f32(c, d, w, true); return (unsigned)w; }
__device__ __forceinline__ float clamp448(float v) { return fminf(fmaxf(v, -448.0f), 448.0f); }
__device__ __forceinline__ float bf2f(unsigned short h) { return __uint_as_float(((unsigned)h) << 16); }
__device__ __forceinline__ float wave_sum(float v) {
#pragma unroll
    for (int o = 1; o < 64; o <<= 1) v += __shfl_xor(v, o);
    return v;
}
__device__ __forceinline__ float wave_max(float v) {
#pragma unroll
    for (int o = 1; o < 64; o <<= 1) v = fmaxf(v, __shfl_xor(v, o));
    return v;
}
__device__ __forceinline__ int wave_min_i(int v) {
#pragma unroll
    for (int o = 1; o < 64; o <<= 1) { int w = __shfl_xor(v, o); v = w < v ? w : v; }
    return v;
}

namespace pg8 {
constexpr int BM = 256, BK = 64, HALF = 128, HTB = HALF * BK * 2, STAGE_BYTES = 8 * HTB;
__device__ __forceinline__ int lds_byte(int r, int c) { const int st = (r >> 4) * 2 + (c >> 5), rr = r & 15, cc = c & 31, ob = rr * 64 + cc * 2; return st * 1024 + (ob ^ (((ob >> 9) & 1) << 5)); }
__device__ __forceinline__ void stage_rc(int b, int& R, int& C) { const int st = b / 1024, sb = b % 1024, swz = sb ^ (((sb >> 9) & 1) << 5); R = (st >> 1) * 16 + swz / 64; C = (st & 1) * 32 + (swz % 64) / 2; }
__device__ __forceinline__ int perm32(int rho) { const int n = rho >> 4, i = rho & 15; return 8 * (i >> 2) + 4 * n + (i & 3); }

struct Unit { int pm, pn, e; unsigned a00, a01, a10, a11; const char* B; };

typedef int i32x4 __attribute__((ext_vector_type(4)));
typedef int i32x8 __attribute__((ext_vector_type(8)));
__device__ __forceinline__ i32x8 cat8(bf16x8 lo, bf16x8 hi) { return __builtin_shufflevector(__builtin_bit_cast(i32x4, lo), __builtin_bit_cast(i32x4, hi), 0, 1, 2, 3, 4, 5, 6, 7); }
template <class Epi, class Sched, bool ALIGN_EPI, bool FP8>
__device__ __forceinline__ void gemm_phase(LAS unsigned char* lds, const char* A, const int Kb, const Sched& S, const Epi& E) {
    const int tid = threadIdx.x, wid = __builtin_amdgcn_readfirstlane(tid >> 6), lane = tid & 63, wr = wid >> 2, wc = wid & 3, fr = lane & 15, fq = lane >> 4;
    int nt = Kb / 128; asm volatile("" : "+s"(nt));
    int R0, C0, R1, C1; stage_rc(tid * 16, R0, C0); stage_rc(tid * 16 + 8192, R1, C1);
    unsigned voffB[2];
    { const int Rb0 = Epi::PERM ? ((R0 & ~31) + perm32(R0 & 31)) : R0, Rb1 = Epi::PERM ? ((R1 & ~31) + perm32(R1 & 31)) : R1;
      voffB[0] = (unsigned)(Rb0 * Kb + C0 * 2); voffB[1] = (unsigned)(Rb1 * Kb + C1 * 2); }
    const size_t kstep = (size_t)(BK * 2);
    const size_t hstep = (size_t)HALF * Kb;
    const unsigned ldsw = (unsigned)wid * 1024u;
    const int aoff = lds_byte(wr * 64 + fr, fq * 8), boff = lds_byte(wc * 32 + fr, fq * 8);
#define PG8_SA(b, h) (((b) * 2 + (h)) * HTB)
#define PG8_SB(b, h) ((4 + (b) * 2 + (h)) * HTB)
#define PG8_STAGEB(bufoff, gbase) do { _Pragma("unroll") for (int _i = 0; _i < 2; ++_i) \
        __builtin_amdgcn_global_load_lds((const unsigned*)((const char*)(gbase) + voffB[_i]), (LAS unsigned*)(lds + (bufoff) + ldsw + _i * 8192), 16, 0, 0); } while (0)
#define PG8_STAGEA(bufoff, kb, o0, o1) do { \
        __builtin_amdgcn_global_load_lds((const unsigned*)(A + (size_t)(o0) + (kb)), (LAS unsigned*)(lds + (bufoff) + ldsw), 16, 0, 0); \
        __builtin_amdgcn_global_load_lds((const unsigned*)(A + (size_t)(o1) + (kb)), (LAS unsigned*)(lds + (bufoff) + ldsw + 8192), 16, 0, 0); } while (0)
#define PG8_LDA(dst, b, h) do { _Pragma("unroll") for (int m = 0; m < 4; ++m) { const i32x4 lo_ = *(const LAS i32x4*)(lds + PG8_SA(b, h) + aoff + m * 2048), hi_ = *(const LAS i32x4*)(lds + PG8_SA(b, h) + aoff + m * 2048 + 1024); \
        dst[m] = __builtin_shufflevector(lo_, hi_, 0, 1, 2, 3, 4, 5, 6, 7); } } while (0)
#define PG8_LDB(dst, b, h) do { _Pragma("unroll") for (int n = 0; n < 2; ++n) { const i32x4 lo_ = *(const LAS i32x4*)(lds + PG8_SB(b, h) + boff + n * 2048), hi_ = *(const LAS i32x4*)(lds + PG8_SB(b, h) + boff + n * 2048 + 1024); \
        dst[n] = __builtin_shufflevector(lo_, hi_, 0, 1, 2, 3, 4, 5, 6, 7); } } while (0)
#define PG8_LO(v) __builtin_bit_cast(bf16x8, __builtin_shufflevector(v, v, 0, 1, 2, 3))
#define PG8_HI(v) __builtin_bit_cast(bf16x8, __builtin_shufflevector(v, v, 4, 5, 6, 7))
#define PG8_MMA(ai, bj, At, Bt) do { __builtin_amdgcn_s_setprio(1); if constexpr (FP8) { _Pragma("unroll") for (int m = 0; m < 4; ++m) _Pragma("unroll") for (int n = 0; n < 2; ++n) \
        asm volatile("s_nop 1\n\tv_mfma_f32_16x16x128_f8f6f4 %0, %1, %2, %0" : "+v"(acc[ai][bj][m][n]) : "v"(Bt[n]), "v"(At[m])); } else { \
        _Pragma("unroll") for (int m = 0; m < 4; ++m) _Pragma("unroll") for (int n = 0; n < 2; ++n) { \
        acc[ai][bj][m][n] = __builtin_amdgcn_mfma_f32_16x16x32_bf16(PG8_LO(Bt[n]), PG8_LO(At[m]), acc[ai][bj][m][n], 0, 0, 0); \
        acc[ai][bj][m][n] = __builtin_amdgcn_mfma_f32_16x16x32_bf16(PG8_HI(Bt[n]), PG8_HI(At[m]), acc[ai][bj][m][n], 0, 0, 0); } } __builtin_amdgcn_s_setprio(0); } while (0)
#define PG8_WAIT_V(n) asm volatile("s_waitcnt vmcnt(" #n ")" ::: "memory")
#define PG8_WAIT_L(n) asm volatile("s_waitcnt lgkmcnt(" #n ")" ::: "memory")
#define PG8_BAR __builtin_amdgcn_s_barrier()
#define PG8_SCHED __builtin_amdgcn_sched_barrier(0)
    Unit cur, nxt; int ui = 0;
    if (!S.next(0, cur, R0, C0, R1, C1)) return;
    f32x4 acc[2][2][4][2];
#pragma unroll
    for (int a = 0; a < 2; ++a)
#pragma unroll
        for (int b = 0; b < 2; ++b)
#pragma unroll
            for (int m = 0; m < 4; ++m)
#pragma unroll
                for (int n = 0; n < 2; ++n) acc[a][b][m][n] = (f32x4){0.f, 0.f, 0.f, 0.f};
    i32x8 At[4], B0[2], B1[2];
    const char* cB = cur.B;
    PG8_STAGEB(PG8_SB(0, 0), cB); PG8_STAGEB(PG8_SB(0, 1), cB + hstep); PG8_STAGEA(PG8_SA(0, 0), 0, cur.a00, cur.a01); PG8_STAGEA(PG8_SA(0, 1), 0, cur.a10, cur.a11);
    if (wr == 1) PG8_BAR;
    PG8_WAIT_V(2); PG8_BAR;
    PG8_STAGEB(PG8_SB(1, 0), cB + kstep); PG8_STAGEA(PG8_SA(1, 0), kstep, cur.a00, cur.a01); PG8_STAGEB(PG8_SB(1, 1), cB + hstep + kstep);
    PG8_WAIT_V(6); PG8_BAR;
    for (;;) {
        const bool has_next = S.next(ui + 1, nxt, R0, C0, R1, C1);
        if (!has_next) nxt = cur;
        const char* nB = nxt.B;
#pragma unroll 1
        for (int t = 0; t < nt; t += 2) {
            const bool last = (t == nt - 2);
            const size_t k1 = (size_t)(t + 1) * kstep;
            const size_t k2 = last ? 0 : (size_t)(t + 2) * kstep, k3 = k2 + kstep;
            const char* b2 = last ? nB : cB + (size_t)(t + 2) * kstep; const char* b3 = b2 + kstep;
            const unsigned s00 = last ? nxt.a00 : cur.a00, s01 = last ? nxt.a01 : cur.a01, s10 = last ? nxt.a10 : cur.a10, s11 = last ? nxt.a11 : cur.a11;
            PG8_LDB(B0, 0, 0); PG8_LDB(B1, 0, 1); PG8_SCHED; PG8_LDA(At, 0, 0); PG8_STAGEA(PG8_SA(1, 1), k1, cur.a10, cur.a11);
            PG8_WAIT_V(8); PG8_WAIT_L(0); PG8_BAR; PG8_MMA(0, 0, At, B0); PG8_MMA(0, 1, At, B1); PG8_BAR; PG8_SCHED;
            PG8_LDA(At, 0, 1); PG8_STAGEB(PG8_SB(0, 0), b2); PG8_STAGEB(PG8_SB(0, 1), b2 + hstep); PG8_STAGEA(PG8_SA(0, 0), k2, s00, s01);
            PG8_WAIT_V(8); PG8_WAIT_L(0); PG8_BAR; PG8_MMA(1, 0, At, B0); PG8_MMA(1, 1, At, B1); PG8_BAR; PG8_SCHED;
            PG8_LDB(B0, 1, 0); PG8_LDB(B1, 1, 1); PG8_SCHED; PG8_LDA(At, 1, 0); PG8_STAGEA(PG8_SA(0, 1), k2, s10, s11);
            PG8_WAIT_V(8); PG8_WAIT_L(0); PG8_BAR; PG8_MMA(0, 0, At, B0); PG8_MMA(0, 1, At, B1); PG8_BAR; PG8_SCHED;
            PG8_LDA(At, 1, 1); PG8_STAGEB(PG8_SB(1, 0), b3); PG8_STAGEB(PG8_SB(1, 1), b3 + hstep); PG8_STAGEA(PG8_SA(1, 0), k3, s00, s01);
            PG8_WAIT_V(8); PG8_WAIT_L(0); PG8_BAR; PG8_MMA(1, 0, At, B0); PG8_MMA(1, 1, At, B1); PG8_BAR; PG8_SCHED;
        }
        if constexpr (ALIGN_EPI) { if (wr == 0) PG8_BAR; }
        if constexpr (FP8) { PG8_SCHED; asm volatile("s_nop 15\n\ts_nop 7" ::: "memory"); PG8_SCHED; }
        E(acc, cur, wr, wc, fr, fq);
        if (!has_next) break;
#pragma unroll
        for (int a = 0; a < 2; ++a)
#pragma unroll
            for (int b = 0; b < 2; ++b)
#pragma unroll
                for (int m = 0; m < 4; ++m)
#pragma unroll
                    for (int n = 0; n < 2; ++n) acc[a][b][m][n] = (f32x4){0.f, 0.f, 0.f, 0.f};
        cur = nxt; cB = nB; ++ui;
        if constexpr (ALIGN_EPI) { if (wr == 1) PG8_BAR; }
    }
    PG8_WAIT_V(0);
    if constexpr (!ALIGN_EPI) { if (wr == 0) PG8_BAR; }
    PG8_BAR;
#undef PG8_SA
#undef PG8_SB
#undef PG8_STAGEA
#undef PG8_STAGEB
#undef PG8_LDA
#undef PG8_LDB
#undef PG8_LO
#undef PG8_HI
#undef PG8_MMA
#undef PG8_WAIT_V
#undef PG8_WAIT_L
#undef PG8_BAR
#undef PG8_SCHED
}

struct DenseSched {
    int nM, nN, nwg, G, c, Kb, dup; const char* Bt;
    __device__ __forceinline__ void init(int Mr, int N, int Kb_, int G_, int c_, const void* Bt_, int dup_) { nM = Mr / BM; nN = N / BM; nwg = nM * nN; G = G_; c = c_; Kb = Kb_; Bt = (const char*)Bt_; dup = dup_; }
    __device__ __forceinline__ bool next(int i, Unit& u, int R0, int C0, int R1, int C1) const {
        const long L = (long)(i / dup) * G + c; if (L >= nwg) return false;
        int wgid = (int)L; { const int q = nwg / 8, r = nwg % 8, xcd = wgid % 8, off = wgid / 8; wgid = (xcd < r ? xcd * (q + 1) : r * (q + 1) + (xcd - r) * q) + off; }
        const int WGM = 8, nig = WGM * nN, gid = wgid / nig, fm = gid * WGM, gsz = (nM - fm) < WGM ? (nM - fm) : WGM;
        u.pm = fm + ((wgid % nig) % gsz); u.pn = (wgid % nig) / gsz; u.e = 0;
        const unsigned rb = (unsigned)u.pm * 256u;
        u.a00 = (rb + R0) * Kb + C0 * 2; u.a01 = (rb + R1) * Kb + C1 * 2; u.a10 = (rb + 128 + R0) * Kb + C0 * 2; u.a11 = (rb + 128 + R1) * Kb + C1 * 2;
        u.B = Bt + (size_t)u.pn * 256 * Kb; return true;
    }
};
struct MoeSched {
    const LAS int* tp; const LAS int* cnt; int NT; int xcd, j; int Kb; const char* W; size_t wstride; const int* ltok; bool gather;
    __device__ __forceinline__ int rd(const LAS int* p) const { return __builtin_amdgcn_readfirstlane(*p); }
    __device__ __forceinline__ bool next(int i, Unit& u, int R0, int C0, int R1, int C1) const {
        const int U = rd(tp + NE) * NT; const int lo = (int)(((long)xcd * U) / 8), hi = (int)(((long)(xcd + 1) * U) / 8);
        const int L = lo + i * 32 + j; if (L >= hi) return false;
        int e = 0;
        for (int q = 1; q < NE; ++q) e = (L >= rd(tp + q) * NT) ? q : e;
        const int tpe = rd(tp + e), nte = rd(tp + e + 1) - tpe, r = L - tpe * NT, pn = r / nte, mt = r % nte;
        u.e = e; u.pn = pn; u.pm = tpe + mt;
        if (gather) {
            const int ce = rd(cnt + e); const int* lt = ltok + (size_t)e * M;
            const int i00 = mt * 256 + R0, i01 = mt * 256 + R1, i10 = i00 + 128, i11 = i01 + 128;
            const unsigned t00 = i00 < ce ? (unsigned)lt[i00] : 0u, t01 = i01 < ce ? (unsigned)lt[i01] : 0u, t10 = i10 < ce ? (unsigned)lt[i10] : 0u, t11 = i11 < ce ? (unsigned)lt[i11] : 0u;
            u.a00 = t00 * Kb + C0 * 2; u.a01 = t01 * Kb + C1 * 2; u.a10 = t10 * Kb + C0 * 2; u.a11 = t11 * Kb + C1 * 2;
        } else {
            const unsigned rb = (unsigned)u.pm * 256u;
            u.a00 = (rb + R0) * Kb + C0 * 2; u.a01 = (rb + R1) * Kb + C1 * 2; u.a10 = (rb + 128 + R0) * Kb + C0 * 2; u.a11 = (rb + 128 + R1) * Kb + C1 * 2;
        }
        u.B = W + (size_t)e * wstride + (size_t)pn * 256 * Kb; return true;
    }
};

struct EpiQkvu {
    static constexpr bool PERM = true; bf16_t* O;
    __device__ __forceinline__ void operator()(const f32x4 (&acc)[2][2][4][2], const Unit& u, int wr, int wc, int fr, int fq) const {
        const int row0 = u.pm * BM + wr * 64 + fr, col0 = u.pn * BM + wc * 32 + 8 * fq; const float sc = (u.pn < 2) ? QSCALE : 1.f;
#pragma unroll
        for (int ai = 0; ai < 2; ++ai)
#pragma unroll
            for (int m = 0; m < 4; ++m) { bf16_t* rowp = O + (size_t)(row0 + ai * HALF + m * 16) * NIN + col0;
#pragma unroll
                for (int bj = 0; bj < 2; ++bj) { const f32x4 v0 = acc[ai][bj][m][0] * sc, v1 = acc[ai][bj][m][1] * sc;
                    u32x4 w; w.x = pk2(v0[0], v0[1]); w.y = pk2(v0[2], v0[3]); w.z = pk2(v1[0], v1[1]); w.w = pk2(v1[2], v1[3]);
                    *(u32x4*)(rowp + bj * HALF) = w; } }
    }
};
struct EpiResF32 {
    static constexpr bool PERM = false; const float* base; float* out;
    __device__ __forceinline__ void operator()(const f32x4 (&acc)[2][2][4][2], const Unit& u, int wr, int wc, int fr, int fq) const {
        const int col0 = u.pn * BM + wc * 32 + 4 * fq;
#pragma unroll
        for (int ai = 0; ai < 2; ++ai)
#pragma unroll
            for (int m = 0; m < 4; ++m) { const size_t off = (size_t)(u.pm * BM + ai * HALF + wr * 64 + m * 16 + fr) * D + col0;
#pragma unroll
                for (int bj = 0; bj < 2; ++bj)
#pragma unroll
                    for (int n = 0; n < 2; ++n) { const f32x4 bs = *(const f32x4*)(base + off + bj * HALF + n * 16); *(f32x4*)(out + off + bj * HALF + n * 16) = bs + acc[ai][bj][m][n]; } }
    }
};
struct EpiSwiglu {
    static constexpr bool PERM = true; unsigned char* ACT; const float* bg; const float* bu;
    __device__ __forceinline__ void operator()(const f32x4 (&acc)[2][2][4][2], const Unit& u, int wr, int wc, int fr, int fq) const {
        const int row0 = u.pm * BM + wr * 64 + fr, col0 = u.pn * 128 + wc * 32 + 8 * fq;
        f32x4 g4[2], u4[2];
#pragma unroll
        for (int n = 0; n < 2; ++n) { g4[n] = *(const f32x4*)(bg + (size_t)u.e * DFF + col0 + 4 * n); u4[n] = *(const f32x4*)(bu + (size_t)u.e * DFF + col0 + 4 * n); }
#pragma unroll
        for (int ai = 0; ai < 2; ++ai)
#pragma unroll
            for (int m = 0; m < 4; ++m) { float a[8];
#pragma unroll
                for (int n = 0; n < 2; ++n)
#pragma unroll
                    for (int j = 0; j < 4; ++j) { const float g = fminf(acc[ai][0][m][n][j] * GU_DESCALE + g4[n][j], 7.0f); const float up = fminf(fmaxf(acc[ai][1][m][n][j] * GU_DESCALE + u4[n][j], -7.0f), 7.0f);
                        const float sg = __builtin_amdgcn_rcpf(1.0f + __builtin_amdgcn_exp2f(-1.702f * 1.4426950408889634f * g)); a[n * 4 + j] = g * sg * (up + 1.0f) * ACT_SCALE; }
                u32x2 w; w.x = pk4_fp8(a[0], a[1], a[2], a[3]); w.y = pk4_fp8(a[4], a[5], a[6], a[7]);
                *(u32x2*)(ACT + (size_t)(row0 + ai * HALF + m * 16) * DFF + col0) = w; }
    }
};
struct EpiDown {
    static constexpr bool PERM = true; bf16_t* Y; const float* bd; const float* lgate; const LAS int* tp;
    __device__ __forceinline__ void operator()(const f32x4 (&acc)[2][2][4][2], const Unit& u, int wr, int wc, int fr, int fq) const {
        const int mt = u.pm - tp[u.e]; const int row0 = u.pm * BM + wr * 64 + fr, col0 = u.pn * BM + wc * 32 + 8 * fq;
        const float* lg = lgate + (size_t)u.e * M + mt * 256 + wr * 64 + fr;
        f32x4 bv[2][2];
#pragma unroll
        for (int bj = 0; bj < 2; ++bj)
#pragma unroll
            for (int n = 0; n < 2; ++n) bv[bj][n] = *(const f32x4*)(bd + (size_t)u.e * D + col0 + bj * HALF + 4 * n);
#pragma unroll
        for (int ai = 0; ai < 2; ++ai)
#pragma unroll
            for (int m = 0; m < 4; ++m) { const float gt = lg[ai * HALF + m * 16]; bf16_t* rowp = Y + (size_t)(row0 + ai * HALF + m * 16) * D + col0;
#pragma unroll
                for (int bj = 0; bj < 2; ++bj) { const f32x4 v0 = (acc[ai][bj][m][0] * DN_DESCALE + bv[bj][0]) * gt, v1 = (acc[ai][bj][m][1] * DN_DESCALE + bv[bj][1]) * gt;
                    u32x4 w; w.x = pk2(v0[0], v0[1]); w.y = pk2(v0[2], v0[3]); w.z = pk2(v1[0], v1[1]); w.w = pk2(v1[2], v1[3]);
                    *(u32x4*)(rowp + bj * HALF) = w; } }
    }
};
}

namespace att {
__device__ __forceinline__ int crow(int r, int hi) { return (r & 3) + 8 * (r >> 2) + 4 * hi; }
__device__ __forceinline__ s16x4 vtr(const LAS unsigned char* p) { typedef short v4 __attribute__((ext_vector_type(4))); return __builtin_bit_cast(s16x4, __builtin_amdgcn_ds_read_tr16_b64_v4i16((LAS v4*)p)); }

__device__ __forceinline__ void attn_unit(int b, int h, int qb, const bf16_t* QKVU, bf16_t* MIX, LAS unsigned char* lds, float lam, const float* subln_g) {
    const int tid = threadIdx.x, lane = tid & 63, r32 = lane & 31, hi = lane >> 5; const int wid = __builtin_amdgcn_readfirstlane(tid >> 6);
    const int map = wid >> 2, wq = wid & 3;
    const long rowbase = (long)b * SEQ; const int q0 = qb * 128;
    const int NT = 2 * qb + 2;
    const bf16_t* Qp = QKVU + (size_t)(rowbase + q0 + wq * 32 + r32) * NIN + h * 128 + map * 64 + hi * 8;
    bf16x8 qr[4];
#pragma unroll
    for (int d0 = 0; d0 < 4; ++d0) qr[d0] = *(const bf16x8*)(Qp + d0 * 16);
    const bf16_t* ksrc[2]; const bf16_t* vsrc[2];
#pragma unroll
    for (int i = 0; i < 2; ++i) { const int p = 2 * wid + i;
        ksrc[i] = QKVU + (size_t)(rowbase + lane) * NIN + 512 + h * 128 + (p >> 3) * 64 + (p & 7) * 8;
        vsrc[i] = QKVU + (size_t)(rowbase + 16 * (p & 3) + (lane >> 2)) * NIN + 1024 + h * 128 + (p >> 2) * 32 + (lane & 3) * 8; }
#define ATT_DMA(t, buf) do { _Pragma("unroll") for (int _i = 0; _i < 2; ++_i) { \
        __builtin_amdgcn_global_load_lds((const unsigned*)(ksrc[_i] + (size_t)(t) * 64 * NIN), (LAS unsigned*)(lds + (buf) * 32768 + (2 * wid + _i) * 1024), 16, 0, 0); \
        __builtin_amdgcn_global_load_lds((const unsigned*)(vsrc[_i] + (size_t)(t) * 64 * NIN), (LAS unsigned*)(lds + (buf) * 32768 + 16384 + (2 * wid + _i) * 1024), 16, 0, 0); } } while (0)
    float m_run = -INFINITY, l_run = 0.f;
    f32x16 o[4];
#pragma unroll
    for (int d0 = 0; d0 < 4; ++d0) o[d0] = f32x16{};
    const int qabs = q0 + wq * 32 + r32;
    ATT_DMA(0, 0);
    for (int t = 0; t < NT; ++t) {
        __syncthreads();
        if (t + 1 < NT) ATT_DMA(t + 1, (t + 1) & 1);
        if (64 * t <= q0 + wq * 32 + 31) {
            const LAS unsigned char* Kb = lds + (t & 1) * 32768 + map * 8192 + hi * 1024 + r32 * 16;
            const LAS unsigned char* Vb = lds + (t & 1) * 32768 + 16384 + ((lane >> 4) & 1) * 32 + (lane & 3) * 8 + (4 * hi + ((lane & 15) >> 2)) * 64;
            f32x16 p0 = f32x16{}, p1 = f32x16{};
#pragma unroll
            for (int d0 = 0; d0 < 4; ++d0) {
                const bf16x8 k0 = *(const LAS bf16x8*)(Kb + d0 * 2048), k1 = *(const LAS bf16x8*)(Kb + d0 * 2048 + 512);
                p0 = __builtin_amdgcn_mfma_f32_32x32x16_bf16(k0, qr[d0], p0, 0, 0, 0);
                p1 = __builtin_amdgcn_mfma_f32_32x32x16_bf16(k1, qr[d0], p1, 0, 0, 0);
            }
            if (t >= NT - 2) {
#pragma unroll
                for (int r = 0; r < 16; ++r) { const int kv = 64 * t + crow(r, hi); if (kv > qabs) p0[r] = -INFINITY; if (kv + 32 > qabs) p1[r] = -INFINITY; }
            }
            float rm = fmaxf(p0[0], p1[0]);
#pragma unroll
            for (int r = 1; r < 16; ++r) rm = fmaxf(rm, fmaxf(p0[r], p1[r]));
            { auto rr = __builtin_amdgcn_permlane32_swap(__float_as_uint(rm), __float_as_uint(rm), false, false); rm = fmaxf(__uint_as_float(rr[0]), __uint_as_float(rr[1])); }
            const float mnew = fmaxf(m_run, rm);
            const float f = __builtin_amdgcn_exp2f(m_run - mnew);
            m_run = mnew;
            float ls = 0.f;
#pragma unroll
            for (int r = 0; r < 16; ++r) { p0[r] = __builtin_amdgcn_exp2f(p0[r] - mnew); p1[r] = __builtin_amdgcn_exp2f(p1[r] - mnew); ls += p0[r] + p1[r]; }
            l_run = l_run * f + ls;
            if (!__all(f == 1.0f)) {
#pragma unroll
                for (int d0 = 0; d0 < 4; ++d0)
#pragma unroll
                    for (int r = 0; r < 16; ++r) o[d0][r] *= f;
            }
            bf16x8 pa[4];
#pragma unroll
            for (int s = 0; s < 2; ++s) {
                u32x4 w0, w1;
                w0.x = pk2(p0[8 * s + 0], p0[8 * s + 1]); w0.y = pk2(p0[8 * s + 2], p0[8 * s + 3]); w0.z = pk2(p0[8 * s + 4], p0[8 * s + 5]); w0.w = pk2(p0[8 * s + 6], p0[8 * s + 7]);
                w1.x = pk2(p1[8 * s + 0], p1[8 * s + 1]); w1.y = pk2(p1[8 * s + 2], p1[8 * s + 3]); w1.z = pk2(p1[8 * s + 4], p1[8 * s + 5]); w1.w = pk2(p1[8 * s + 6], p1[8 * s + 7]);
                pa[s] = __builtin_bit_cast(bf16x8, w0); pa[2 + s] = __builtin_bit_cast(bf16x8, w1);
            }
#pragma unroll
            for (int d0 = 0; d0 < 4; ++d0) {
#pragma unroll
                for (int ks = 0; ks < 4; ++ks) {
                    const s16x4 lo = vtr(Vb + (d0 * 4 + ks) * 1024), hh = vtr(Vb + (d0 * 4 + ks) * 1024 + 512);
                    const bf16x8 vf = (bf16x8){lo[0], lo[1], lo[2], lo[3], hh[0], hh[1], hh[2], hh[3]};
                    o[d0] = __builtin_amdgcn_mfma_f32_32x32x16_bf16(vf, pa[ks], o[d0], 0, 0, 0);
                }
            }
        }
    }
#undef ATT_DMA
    { auto rr = __builtin_amdgcn_permlane32_swap(__float_as_uint(l_run), __float_as_uint(l_run), false, false); l_run = __uint_as_float(rr[0]) + __uint_as_float(rr[1]); }
    const float rl = 1.0f / l_run;
    __syncthreads();
    LAS float* xs = (LAS float*)lds + wq * 4096 + lane;
    if (map == 1) {
#pragma unroll
        for (int d0 = 0; d0 < 4; ++d0)
#pragma unroll
            for (int r = 0; r < 16; ++r) xs[(d0 * 16 + r) * 64] = o[d0][r] * rl;
    }
    __syncthreads();
    if (map == 0) {
        float ss = 0.f;
#pragma unroll
        for (int d0 = 0; d0 < 4; ++d0)
#pragma unroll
            for (int r = 0; r < 16; ++r) { const float a = o[d0][r] * rl - lam * xs[(d0 * 16 + r) * 64]; o[d0][r] = a; ss += a * a; }
        { auto rr = __builtin_amdgcn_permlane32_swap(__float_as_uint(ss), __float_as_uint(ss), false, false); ss = __uint_as_float(rr[0]) + __uint_as_float(rr[1]); }
        const float rs = rsqrtf(ss * (1.0f / 128.0f) + RMS_EPS) * (1.0f - LAMBDA_INIT);
        bf16_t* Op = MIX + (size_t)(rowbase + qabs) * D + h * 128 + 4 * hi;
#pragma unroll
        for (int d0 = 0; d0 < 4; ++d0)
#pragma unroll
            for (int g = 0; g < 4; ++g) { const int dv = d0 * 32 + 8 * g + 4 * hi; const f32x4 sg = *(const f32x4*)(subln_g + dv);
                u32x2 w; w.x = pk2(o[d0][4 * g + 0] * rs * sg[0], o[d0][4 * g + 1] * rs * sg[1]); w.y = pk2(o[d0][4 * g + 2] * rs * sg[2], o[d0][4 * g + 3] * rs * sg[3]);
                *(u32x2*)(Op + d0 * 32 + 8 * g) = w; }
    }
    __syncthreads();
}
}

__device__ __forceinline__ void pool_unit(int tile, int g, const bf16_t* QKVU, const bf16_t* WPt, const float* b_pool, const float* pool_scale, bf16_t* MIX, LAS unsigned char* lds) {
    const int tid = threadIdx.x, lane = tid & 63, fr = lane & 15, fq = lane >> 4; const int wid = __builtin_amdgcn_readfirstlane(tid >> 6);
    const int t0 = tile * 128, s0 = t0 % SEQ, w = 2 << g;
    LAS float* U = (LAS float*)lds;
    LAS bf16_t* Z = (LAS bf16_t*)(lds + 144 * 132 * 4);
    for (int it = tid; it < 144 * 16; it += 512) { const int r = it >> 4, c8 = (it & 15) * 8; const int trow = t0 - 16 + r;
        f32x4 lo = {0.f, 0.f, 0.f, 0.f}, hi4 = {0.f, 0.f, 0.f, 0.f};
        if (s0 + r - 16 >= 0) { const u32x4 v = *(const u32x4*)(QKVU + (size_t)trow * NIN + 1536 + g * 128 + c8);
            lo = (f32x4){__uint_as_float(v.x << 16), __uint_as_float(v.x & 0xffff0000u), __uint_as_float(v.y << 16), __uint_as_float(v.y & 0xffff0000u)};
            hi4 = (f32x4){__uint_as_float(v.z << 16), __uint_as_float(v.z & 0xffff0000u), __uint_as_float(v.w << 16), __uint_as_float(v.w & 0xffff0000u)}; }
        *(LAS f32x4*)(U + r * 132 + c8) = lo; *(LAS f32x4*)(U + r * 132 + c8 + 4) = hi4; }
    __syncthreads();
    for (int it = tid; it < 128 * 64; it += 512) { const int r = it >> 6, c2 = (it & 63) * 2; float a0 = 0.f, a1 = 0.f;
        for (int j = 0; j < w; ++j) { const f32x2 v = *(const LAS f32x2*)(U + (16 + r - j) * 132 + c2); a0 += v.x; a1 += v.y; }
        const int pos1 = s0 + r + 1; const float inv = 1.0f / (float)(pos1 < w ? pos1 : w); const f32x2 uu = *(const LAS f32x2*)(U + (16 + r) * 132 + c2);
        *(LAS unsigned*)(Z + r * 136 + c2) = pk2(a0 * inv - uu.x, a1 * inv - uu.y); }
    __syncthreads();
    f32x4 acc[8];
#pragma unroll
    for (int nb = 0; nb < 8; ++nb) acc[nb] = (f32x4){0.f, 0.f, 0.f, 0.f};
#pragma unroll
    for (int ks = 0; ks < 4; ++ks) { const bf16x8 zf = *(const LAS bf16x8*)(Z + (wid * 16 + fr) * 136 + ks * 32 + fq * 8);
#pragma unroll
        for (int nb = 0; nb < 8; ++nb) { const bf16x8 wf = *(const bf16x8*)(WPt + (size_t)g * 16384 + (nb * 16 + fr) * 128 + ks * 32 + fq * 8); acc[nb] = __builtin_amdgcn_mfma_f32_16x16x32_bf16(wf, zf, acc[nb], 0, 0, 0); } }
    bf16_t* Op = MIX + (size_t)(t0 + wid * 16 + fr) * D + 512 + g * 128;
#pragma unroll
    for (int nb = 0; nb < 8; ++nb) { const int c = nb * 16 + 4 * fq; const f32x4 bb = *(const f32x4*)(b_pool + g * 128 + c), ps = *(const f32x4*)(pool_scale + g * 128 + c); const f32x4 v = (acc[nb] + bb) * ps;
        u32x2 wv; wv.x = pk2(v[0], v[1]); wv.y = pk2(v[2], v[3]); *(u32x2*)(Op + c) = wv; }
    __syncthreads();
}

__device__ __forceinline__ void transpose_item(const float* W, int N, int k0, int n0, bf16_t* WT, int K, int drow0, LAS float* scr, int lane) {
#pragma unroll 8
    for (int i = 0; i < 32; ++i) { const int kk = 2 * i + (lane >> 5); scr[kk * 33 + (lane & 31)] = W[(size_t)(k0 + kk) * N + n0 + (lane & 31)]; }
    asm volatile("s_waitcnt lgkmcnt(0)" ::: "memory");
    const int c = lane & 7;
#pragma unroll
    for (int j = 0; j < 4; ++j) { const int n = (lane >> 3) + 8 * j; const LAS float* s = scr + (8 * c) * 33 + n;
        u32x4 o; o.x = pk2(s[0 * 33], s[1 * 33]); o.y = pk2(s[2 * 33], s[3 * 33]); o.z = pk2(s[4 * 33], s[5 * 33]); o.w = pk2(s[6 * 33], s[7 * 33]);
        *(u32x4*)(WT + (size_t)(drow0 + n) * K + k0 + 8 * c) = o; }
    asm volatile("s_waitcnt lgkmcnt(0)" ::: "memory");
}
__device__ __forceinline__ void transpose_item_fp8(const float* W, int N, int k0, int n0, unsigned char* WT, int K, int drow0, LAS float* scr, int lane) {
#pragma unroll 8
    for (int i = 0; i < 32; ++i) { const int kk = 2 * i + (lane >> 5); scr[kk * 33 + (lane & 31)] = W[(size_t)(k0 + kk) * N + n0 + (lane & 31)]; }
    asm volatile("s_waitcnt lgkmcnt(0)" ::: "memory");
    const int c = lane & 3;
#pragma unroll
    for (int j = 0; j < 2; ++j) { const int n = (lane >> 2) + 16 * j; const LAS float* s = scr + (16 * c) * 33 + n;
        float v[16];
#pragma unroll
        for (int i = 0; i < 16; ++i) v[i] = clamp448(s[i * 33] * W_SCALE);
        u32x4 o; o.x = pk4_fp8(v[0], v[1], v[2], v[3]); o.y = pk4_fp8(v[4], v[5], v[6], v[7]); o.z = pk4_fp8(v[8], v[9], v[10], v[11]); o.w = pk4_fp8(v[12], v[13], v[14], v[15]);
        *(u32x4*)(WT + (size_t)(drow0 + n) * K + k0 + 16 * c) = o; }
    asm volatile("s_waitcnt lgkmcnt(0)" ::: "memory");
}
__device__ __forceinline__ void rms_row_to_bf16(const float* xrow, const float* g, bf16_t* orow, int lane) {
    const f32x4* xr = (const f32x4*)xrow + lane; const f32x4* gr = (const f32x4*)g + lane;
    f32x4 v[4]; float s = 0.f;
#pragma unroll
    for (int j = 0; j < 4; ++j) { v[j] = xr[64 * j]; s += (v[j].x * v[j].x + v[j].y * v[j].y) + (v[j].z * v[j].z + v[j].w * v[j].w); }
    const float rstd = rsqrtf(wave_sum(s) * (1.f / D) + RMS_EPS);
    u32x2* o8 = (u32x2*)orow + lane;
#pragma unroll
    for (int j = 0; j < 4; ++j) { const f32x4 gg = gr[64 * j]; u32x2 w; w.x = pk2(v[j].x * rstd * gg.x, v[j].y * rstd * gg.y); w.y = pk2(v[j].z * rstd * gg.z, v[j].w * rstd * gg.w); o8[64 * j] = w; }
}


#define XB_TMO      128
#define XB_XCNT(j)  (256  + 64 * (j))
#define XB_XSUB(j)  (1280 + 64 * (j))
#define XB_XGEN(j)  (2304 + 64 * (j))
#define XB_TOP      3328
#define XB_TOPGEN   3392
#define XCD_BAR_WORDS 3456
#define XB_SPIN_CAP (1u << 18)
__device__ __forceinline__ unsigned xb_ld(unsigned* p)              { return __hip_atomic_load(p, __ATOMIC_RELAXED, __HIP_MEMORY_SCOPE_AGENT); }
__device__ __forceinline__ unsigned xb_add(unsigned* p, unsigned v) { return __hip_atomic_fetch_add(p, v, __ATOMIC_RELAXED, __HIP_MEMORY_SCOPE_AGENT); }
__device__ __forceinline__ unsigned xb_xcc_id() { return (unsigned)__builtin_amdgcn_s_getreg((3 << 11) | 20) & 0xFu; }
#define XB_SPIN(cond, bar) do { unsigned _sp = 0; while (cond) { __builtin_amdgcn_s_sleep(1); \
    if ((++_sp & 255u) == 0u) { if (xb_ld(&(bar)[XB_TMO])) break; if (_sp > XB_SPIN_CAP) { atomicAdd(&(bar)[XB_TMO], 1u); break; } } } } while (0)
struct XcdBarrier { unsigned* bar; unsigned x; volatile LAS unsigned* st; };
__device__ __forceinline__ XcdBarrier xcd_barrier_post(unsigned* bar, volatile LAS unsigned* st) {
    XcdBarrier b; b.bar = bar; b.x = xb_xcc_id(); b.st = st;
    if (threadIdx.x == 0) (void)xb_add(&bar[XB_XCNT(b.x)], 1u);
    return b;
}
__device__ __forceinline__ void xcd_barrier_complete(unsigned* bar, unsigned x, unsigned& nloc, unsigned& nx) {
    const unsigned G = gridDim.x * gridDim.y * gridDim.z;
    unsigned sum, cnt, mine, sp = 0u;
    for (;;) {
        sum = 0u; cnt = 0u; mine = 0u;
#pragma unroll
        for (unsigned j = 0; j < 16; ++j) { const unsigned c = xb_ld(&bar[XB_XCNT(j)]); sum += c; cnt += (c > 0u) ? 1u : 0u; mine = (j == x) ? c : mine; }
        if (sum == G) break;
        __builtin_amdgcn_s_sleep(1);
        if ((++sp & 255u) == 0u) { if (xb_ld(&bar[XB_TMO])) break; if (sp > XB_SPIN_CAP) { atomicAdd(&bar[XB_TMO], 1u); break; } }
    }
    nloc = mine > 0u ? mine : 1u; nx = cnt > 0u ? cnt : 1u;
}
__device__ __forceinline__ void xcd_barrier(const XcdBarrier& b) {
    asm volatile("s_waitcnt vmcnt(0)" ::: "memory");
    __syncthreads();
    if (threadIdx.x == 0) {
        unsigned* bar = b.bar;
        __builtin_amdgcn_s_waitcnt(0);
        unsigned nloc = b.st[0], nx = b.st[1];
        if (nloc == 0u) { xcd_barrier_complete(bar, b.x, nloc, nx); b.st[0] = nloc; b.st[1] = nx; }
        const unsigned old = xb_add(&bar[XB_XSUB(b.x)], 1u);
        const unsigned gen = old / nloc;
        if (old + 1u == (gen + 1u) * nloc) {
            __builtin_amdgcn_fence(__ATOMIC_RELEASE, "agent");
            asm volatile("s_waitcnt vmcnt(0)" ::: "memory");
            const unsigned og = xb_add(&bar[XB_TOP], 1u);
            const unsigned tg = og / nx;
            if (og + 1u == (tg + 1u) * nx) xb_add(&bar[XB_TOPGEN], 1u);
            else XB_SPIN(xb_ld(&bar[XB_TOPGEN]) == tg, bar);
            __builtin_amdgcn_fence(__ATOMIC_ACQUIRE, "agent");
            xb_add(&bar[XB_XGEN(b.x)], 1u);
            asm volatile("s_waitcnt vmcnt(0)" ::: "memory");
        } else {
            XB_SPIN(xb_ld(&bar[XB_XGEN(b.x)]) == gen, bar);
            __builtin_amdgcn_fence(__ATOMIC_ACQUIRE, "agent");
            asm volatile("s_waitcnt vmcnt(0)" ::: "memory");
        }
    }
    __syncthreads();
}

struct Args {
    const float *x, *norm1_g, *w_in, *lq1, *lk1, *lq2, *lk2, *subln_g, *w_pool, *b_pool, *pool_scale, *w_out, *norm2_g, *router_w, *router_b,
                *w_gate, *b_gate, *w_up, *b_up, *w_down, *b_down, *final_g;
    float* out; unsigned char* ws; int ph_lo, ph_hi;
};

__global__ void __launch_bounds__(512, 2) mk_fwd(Args a) {
    extern __shared__ __attribute__((aligned(16))) unsigned char lds_raw[];
    LAS unsigned char* lds = (LAS unsigned char*)lds_raw;
    const int tid = threadIdx.x, lane = tid & 63; const int wave = __builtin_amdgcn_readfirstlane(tid >> 6);
    const int G = gridDim.x, bx = blockIdx.x; const int vcu = (G % 8 == 0) ? (bx % 8) * (G / 8) + bx / 8 : bx;
    unsigned char* ws = a.ws;
    unsigned* ctl = (unsigned*)(ws + WS_CTL);
    bf16_t* WIN = (bf16_t*)(ws + WS_WIN); bf16_t* WOUT = (bf16_t*)(ws + WS_WOUT); bf16_t* WPOOL = (bf16_t*)(ws + WS_WPOOL);
    bf16_t* WD = (bf16_t*)(ws + WS_WD); bf16_t* WGU = (bf16_t*)(ws + WS_WGU); bf16_t* ACT = (bf16_t*)(ws + WS_ACT);
    bf16_t* XN = (bf16_t*)(ws + WS_XN); bf16_t* QKVU = (bf16_t*)(ws + WS_QKVU); bf16_t* MIX = (bf16_t*)(ws + WS_MIX); bf16_t* Y = (bf16_t*)(ws + WS_Y);
    int* TOKE = (int*)(ws + WS_TOKE); int* TOKP = (int*)(ws + WS_TOKP); int* LTOK = (int*)(ws + WS_LTOK); float* LGATE = (float*)(ws + WS_LGATE);
    float* x1 = a.out;
    LAS int* ldsx = (LAS int*)(lds + LDSX_OFF);
    const int lo = a.ph_lo, hi = a.ph_hi;
#define IN(k) (lo <= (k) && (k) < hi)
#if MK_N_LAUNCHES == 1
    if (tid < 2) ldsx[248 + tid] = 0;
    __syncthreads();
    const XcdBarrier gbar = xcd_barrier_post(ctl + CW_BAR, (volatile LAS unsigned*)(ldsx + 248));
#define GRID_BAR() do { xcd_barrier(gbar); } while (0)
#else
#define GRID_BAR() do { } while (0)
#endif
    const int gw = vcu * 8 + wave, NGW = G * 8;

    if (IN(0)) {
      for (int rep = 0; rep < REP0; ++rep) {
        LAS float* scr = (LAS float*)(lds + wave * 16384);
        constexpr int I_EXP = 96 * 512, I_IN = 16 * 64, I_OUT = 512, I_POOL = 32, NITEMS = I_EXP + I_IN + I_OUT + I_POOL;
        for (int it = gw; it < NITEMS; it += NGW) {
            int r = it;
            if (r < I_EXP) { const int mi = r >> 9, e = mi / 3, which = mi % 3, q = r & 511, kb = q >> 5, nb = q & 31, n0 = nb * 32;
                if (which == 2) transpose_item_fp8(a.w_down + (size_t)e * D * D, D, kb * 64, n0, (unsigned char*)WD + (size_t)e * D * D, D, n0, scr, lane);
                else transpose_item_fp8((which == 0 ? a.w_gate : a.w_up) + (size_t)e * D * D, D, kb * 64, n0, (unsigned char*)WGU + (size_t)e * 2048 * D, D, (n0 >> 7) * 256 + which * 128 + (n0 & 127), scr, lane);
                continue; }
            r -= I_EXP;
            if (r < I_IN) { const int kb = r >> 6, nb = r & 63; transpose_item(a.w_in, NIN, kb * 64, nb * 32, WIN, D, nb * 32, scr, lane); continue; }
            r -= I_IN;
            if (r < I_OUT) { const int kb = r >> 5, nb = r & 31; transpose_item(a.w_out, D, kb * 64, nb * 32, WOUT, D, nb * 32, scr, lane); continue; }
            r -= I_OUT;
            { const int g = r >> 3, q = r & 7, kb = q >> 2, nb = q & 3; transpose_item(a.w_pool + (size_t)g * 16384, 128, kb * 64, nb * 32, WPOOL + (size_t)g * 16384, 128, nb * 32, scr, lane); }
        }
        for (int m = gw; m < M; m += NGW) rms_row_to_bf16(a.x + (size_t)m * D, a.norm1_g, XN + (size_t)m * D, lane);
      }
        if (IN(1)) GRID_BAR();
    }

    if (IN(1)) {
        pg8::DenseSched S; S.init(M, NIN, D * 2, G, bx, WIN, REP1);
        pg8::EpiQkvu E{QKVU};
        pg8::gemm_phase<pg8::EpiQkvu, pg8::DenseSched, true, false>(lds, (const char*)XN, D * 2, S, E);
        if (IN(2)) GRID_BAR();
    }

    if (IN(2)) {
        float s1 = 0.f, s2 = 0.f;
        for (int i = 0; i < 64; ++i) { s1 += a.lq1[i] * a.lk1[i]; s2 += a.lq2[i] * a.lk2[i]; }
        const float lam = __expf(s1) - __expf(s2) + LAMBDA_INIT;
        for (int rep = 0; rep < REP2; ++rep) for (int p = vcu; p < 256; p += G) { const int bh = p >> 3, j = p & 7;
            att::attn_unit(bh >> 2, bh & 3, 15 - j, QKVU, MIX, lds, lam, a.subln_g);
            att::attn_unit(bh >> 2, bh & 3, j, QKVU, MIX, lds, lam, a.subln_g); }
        for (int rep = 0; rep < REPPOOL; ++rep) for (int u = vcu; u < 512; u += G) pool_unit(u >> 2, u & 3, QKVU, WPOOL, a.b_pool, a.pool_scale, MIX, lds);
        if (IN(3)) GRID_BAR();
    }

    if (IN(3)) {
        pg8::DenseSched S; S.init(M, D, D * 2, G, bx, WOUT, REP3);
        pg8::EpiResF32 E{a.x, x1};
        pg8::gemm_phase<pg8::EpiResF32, pg8::DenseSched, true, false>(lds, (const char*)MIX, D * 2, S, E);
        if (IN(4)) GRID_BAR();
    }

    if (IN(4)) {
      for (int rep = 0; rep < REP4; ++rep) {
        const bool dummy = rep + 1 < REP4;
        unsigned* cntp = ctl + CW_CNT + (dummy ? 32 : 0);
        int* LTOKw = dummy ? (int*)(ws + WS_ACT) : LTOK; float* LGATEw = dummy ? (float*)(ws + WS_ACT + 2 * MiB) : LGATE;
        int* TOKEw = dummy ? (int*)(ws + WS_ACT + 4 * MiB) : TOKE; int* TOKPw = dummy ? (int*)(ws + WS_ACT + 5 * MiB) : TOKP;
        __syncthreads();
        for (int it = tid; it < 1024 * 8; it += 512) { const int c = it >> 3, ch = it & 7; const f32x4 v = *(const f32x4*)(a.router_w + (size_t)c * NE + ch * 4);
            *(LAS f32x4*)(lds + (c ^ ((c >> 5) & 1)) * 128 + ((ch ^ ((c >> 2) & 7)) * 16)) = v; }
        if (tid < 32) ldsx[128 + tid] = 0;
        __syncthreads();
        LAS int* pend = (LAS int*)(lds + LDSX_OFF + 1024);
        unsigned char* H8 = (unsigned char*)XN;
        int nloc = 0;
        f32x4 xn4[4];
        if (gw < M) {
#pragma unroll
            for (int j = 0; j < 4; ++j) xn4[j] = *((const f32x4*)(x1 + (size_t)gw * D) + lane + 64 * j);
        }
        for (int m = gw; m < M; m += NGW, ++nloc) {
            f32x4 xv[4]; float ss = 0.f;
#pragma unroll
            for (int j = 0; j < 4; ++j) { xv[j] = xn4[j]; ss += (xv[j].x * xv[j].x + xv[j].y * xv[j].y) + (xv[j].z * xv[j].z + xv[j].w * xv[j].w); }
            if (m + NGW < M) {
#pragma unroll
                for (int j = 0; j < 4; ++j) xn4[j] = *((const f32x4*)(x1 + (size_t)(m + NGW) * D) + lane + 64 * j);
            }
            const float rstd = rsqrtf(wave_sum(ss) * (1.f / D) + RMS_EPS);
            float hv[16];
#pragma unroll
            for (int j = 0; j < 4; ++j) { const f32x4 gg = *((const f32x4*)a.norm2_g + lane + 64 * j);
                hv[4 * j + 0] = xv[j].x * rstd * gg.x; hv[4 * j + 1] = xv[j].y * rstd * gg.y; hv[4 * j + 2] = xv[j].z * rstd * gg.z; hv[4 * j + 3] = xv[j].w * rstd * gg.w;
                *((unsigned*)(H8 + (size_t)m * D) + lane + 64 * j) = pk4_fp8(clamp448(hv[4 * j + 0] * H_SCALE), clamp448(hv[4 * j + 1] * H_SCALE), clamp448(hv[4 * j + 2] * H_SCALE), clamp448(hv[4 * j + 3] * H_SCALE)); }
            float lg[32];
#pragma unroll
            for (int e = 0; e < 32; ++e) lg[e] = 0.f;
            const int sw = lane & 7;
#pragma unroll
            for (int q = 0; q < 16; ++q) { const int c = 4 * lane + 256 * (q >> 2) + (q & 3); const LAS unsigned char* rp = lds + (c ^ ((lane >> 3) & 1)) * 128;
#pragma unroll
                for (int ch = 0; ch < 8; ++ch) { const f32x4 w = *(const LAS f32x4*)(rp + ((ch ^ sw) * 16));
                    lg[ch * 4 + 0] += hv[q] * w.x; lg[ch * 4 + 1] += hv[q] * w.y; lg[ch * 4 + 2] += hv[q] * w.z; lg[ch * 4 + 3] += hv[q] * w.w; } }
            float v16[16];
#pragma unroll
            for (int e = 0; e < 16; ++e) { const float mine = (lane & 32) ? lg[e + 16] : lg[e], oth = (lane & 32) ? lg[e] : lg[e + 16]; v16[e] = mine + __shfl_xor(oth, 32); }
            float v8[8];
#pragma unroll
            for (int e = 0; e < 8; ++e) { const float mine = (lane & 16) ? v16[e + 8] : v16[e], oth = (lane & 16) ? v16[e] : v16[e + 8]; v8[e] = mine + __shfl_xor(oth, 16); }
            float v4[4];
#pragma unroll
            for (int e = 0; e < 4; ++e) { const float mine = (lane & 8) ? v8[e + 4] : v8[e], oth = (lane & 8) ? v8[e] : v8[e + 4]; v4[e] = mine + __shfl_xor(oth, 8); }
            float v2[2];
#pragma unroll
            for (int e = 0; e < 2; ++e) { const float mine = (lane & 4) ? v4[e + 2] : v4[e], oth = (lane & 4) ? v4[e] : v4[e + 2]; v2[e] = mine + __shfl_xor(oth, 4); }
            float v1; { const float mine = (lane & 2) ? v2[1] : v2[0], oth = (lane & 2) ? v2[0] : v2[1]; v1 = mine + __shfl_xor(oth, 2); }
            v1 += __shfl_xor(v1, 1);
            const int myexp = ((lane >> 5) & 1) * 16 + ((lane >> 4) & 1) * 8 + ((lane >> 3) & 1) * 4 + ((lane >> 2) & 1) * 2 + ((lane >> 1) & 1);
            float logit = v1 + a.router_b[myexp];
            int es[4]; float vs[4];
#pragma unroll
            for (int k = 0; k < 4; ++k) { const float mx = wave_max(logit); const int cand = (logit == mx) ? myexp : 99; const int em = wave_min_i(cand); es[k] = em; vs[k] = mx; if (myexp == em) logit = -INFINITY; }
            const float e1 = __expf(vs[1] - vs[0]), e2 = __expf(vs[2] - vs[0]), e3 = __expf(vs[3] - vs[0]); const float inv = 1.0f / (1.0f + e1 + e2 + e3);
            const float gs[4] = {inv, e1 * inv, e2 * inv, e3 * inv};
            if (lane < 4) { const int k = lane; const int e = k == 0 ? es[0] : k == 1 ? es[1] : k == 2 ? es[2] : es[3]; const float gt = k == 0 ? gs[0] : k == 1 ? gs[1] : k == 2 ? gs[2] : gs[3];
                const int rank = __hip_atomic_fetch_add((LAS int*)(ldsx + 128 + e), 1, __ATOMIC_RELAXED, __HIP_MEMORY_SCOPE_WORKGROUP);
                LAS int* pe = pend + ((wave * 8 + nloc) * 4 + k) * 4; pe[0] = e; pe[1] = rank; pe[2] = __float_as_int(gt); pe[3] = m; }
        }
        if (lane == 0) ldsx[224 + wave] = nloc;
        __syncthreads();
        if (tid < 32) ldsx[192 + tid] = (int)atomicAdd(cntp + tid, (unsigned)ldsx[128 + tid]);
        __syncthreads();
        if (tid < 256) { const int w8 = tid >> 5, rem = tid & 31, nl = rem >> 2, k = rem & 3;
            if (nl < ldsx[224 + w8]) { LAS int* pe = pend + ((w8 * 8 + nl) * 4 + k) * 4; const int e = pe[0], pos = ldsx[192 + e] + pe[1], m = pe[3];
                LTOKw[(size_t)e * M + pos] = m; LGATEw[(size_t)e * M + pos] = __int_as_float(pe[2]); TOKEw[m * 4 + k] = e; TOKPw[m * 4 + k] = pos; } }
      }
        if (IN(5)) GRID_BAR();
    }

    if (IN(5) || IN(6) || IN(7)) {
        __syncthreads();
        if (tid < 32) ldsx[64 + tid] = (int)__hip_atomic_load(ctl + CW_CNT + tid, __ATOMIC_RELAXED, __HIP_MEMORY_SCOPE_AGENT);
        __syncthreads();
        if (tid == 0) { int acc = 0; for (int e = 0; e < NE; ++e) { ldsx[e] = acc; acc += (ldsx[64 + e] + 255) >> 8; } ldsx[NE] = acc; }
        __syncthreads();
    }

    if (IN(5)) {
        pg8::MoeSched S{ldsx, ldsx + 64, 8, vcu / (G / 8), vcu % (G / 8), D, (const char*)WGU, (size_t)2048 * D, LTOK, true};
        pg8::EpiSwiglu E{(unsigned char*)ACT, a.b_gate, a.b_up};
        for (int rep = 0; rep < REP5; ++rep) pg8::gemm_phase<pg8::EpiSwiglu, pg8::MoeSched, true, true>(lds, (const char*)XN, D, S, E);
        if (IN(6)) GRID_BAR();
    }

    if (IN(6)) {
        pg8::MoeSched S{ldsx, ldsx + 64, 4, vcu / (G / 8), vcu % (G / 8), DFF, (const char*)WD, (size_t)D * DFF, LTOK, false};
        pg8::EpiDown E{Y, a.b_down, LGATE, ldsx};
        for (int rep = 0; rep < REP6; ++rep) pg8::gemm_phase<pg8::EpiDown, pg8::MoeSched, true, true>(lds, (const char*)ACT, DFF, S, E);
        if (IN(7)) GRID_BAR();
    }

    if (IN(7)) {
      for (int rep = 0; rep < REP7; ++rep) {
        float* outp = (rep + 1 < REP7) ? (float*)(ws + WS_ACT) : a.out;
        for (int m = gw; m < M; m += NGW) {
            const bf16_t* yr[4];
#pragma unroll
            for (int k = 0; k < 4; ++k) { const int e = TOKE[m * 4 + k], pos = TOKP[m * 4 + k]; yr[k] = Y + ((size_t)ldsx[e] * 256 + pos) * D; }
            f32x4 v[4]; float ss = 0.f;
#pragma unroll
            for (int j = 0; j < 4; ++j) { v[j] = *((const f32x4*)(x1 + (size_t)m * D) + lane + 64 * j);
#pragma unroll
                for (int k = 0; k < 4; ++k) { const u32x2 yv = *((const u32x2*)yr[k] + lane + 64 * j);
                    v[j].x += __uint_as_float(yv.x << 16); v[j].y += __uint_as_float(yv.x & 0xffff0000u); v[j].z += __uint_as_float(yv.y << 16); v[j].w += __uint_as_float(yv.y & 0xffff0000u); }
                ss += (v[j].x * v[j].x + v[j].y * v[j].y) + (v[j].z * v[j].z + v[j].w * v[j].w); }
            const float rstd = rsqrtf(wave_sum(ss) * (1.f / D) + RMS_EPS);
#pragma unroll
            for (int j = 0; j < 4; ++j) { const f32x4 gg = *((const f32x4*)a.final_g + lane + 64 * j); *((f32x4*)(outp + (size_t)m * D) + lane + 64 * j) = v[j] * rstd * gg; }
        }
      }
    }
#undef IN
#undef GRID_BAR
}

extern "C" void kernel_launch(void* const* d_in, const int* in_sizes, int n_in, void* d_out, int out_size, void* d_ws, size_t ws_size, hipStream_t stream) {
    static int grid = 0;
    if (grid == 0) {
        if (n_in != 22 || in_sizes[0] != M * D || out_size != M * D || ws_size < WS_END) { fprintf(stderr, "kernel_launch: unexpected shapes / workspace (n_in %d, ws %zu)\n", n_in, ws_size); grid = -1; return; }
        int dev = 0, cus = 0, per_cu = 0;
        (void)hipGetDevice(&dev); (void)hipDeviceGetAttribute(&cus, hipDeviceAttributeMultiprocessorCount, dev);
        (void)hipFuncSetAttribute((const void*)mk_fwd, hipFuncAttributeMaxDynamicSharedMemorySize, LDS_BYTES);
        (void)hipOccupancyMaxActiveBlocksPerMultiprocessor(&per_cu, (const void*)mk_fwd, 512, LDS_BYTES);
        (void)hipGetLastError();
        if (per_cu < 1) { fprintf(stderr, "kernel_launch: occupancy query says %d blocks per CU\n", per_cu); grid = -1; return; }
        grid = cus;
        if (grid % 8 != 0) grid -= grid % 8;
    }
    if (grid < 0) return;
    (void)hipMemsetAsync((char*)d_ws + WS_CTL, 0, CTL_ZERO_BYTES, stream);
    Args a{};
    const float** f = (const float**)&a;
    for (int i = 0; i < 22; ++i) f[i] = (const float*)d_in[i];
    a.out = (float*)d_out; a.ws = (unsigned char*)d_ws;
#if MK_N_LAUNCHES == 1
    a.ph_lo = 0; a.ph_hi = 8;
    void* args[] = {&a};
    hipError_t e = hipLaunchCooperativeKernel((const void*)mk_fwd, dim3(grid), dim3(512), args, LDS_BYTES, stream);
    if (e != hipSuccess) fprintf(stderr, "cooperative launch failed: %s (grid %d)\n", hipGetErrorString(e), grid);
#else
    for (int p = 0; p < 8; ++p) { a.ph_lo = p; a.ph_hi = p + 1; hipLaunchKernelGGL(mk_fwd, dim3(grid), dim3(512), LDS_BYTES, stream, a); }
#endif
}
```

```cpp
#include <hip/hip_runtime.h>
#include <hip/hip_cooperative_groups.h>
#include <cstdio>
#include <cstdint>
namespace cg = cooperative_groups;

#ifndef MK_N_LAUNCHES
#define MK_N_LAUNCHES 1
#endif

#ifndef REP0
#define REP0 1
#endif
#ifndef REP1
#define REP1 1
#endif
#ifndef REP2
#define REP2 1
#endif
#ifndef REP3
#define REP3 1
#endif
#ifndef REPPOOL
#define REPPOOL 1
#endif
#ifndef REP4
#define REP4 1
#endif
#ifndef REP7
#define REP7 1
#endif
#ifndef REP5
#define REP5 1
#endif
#ifndef REP6
#define REP6 1
#endif
#define LAS __attribute__((address_space(3)))
#define GAS __attribute__((address_space(1)))
typedef unsigned short bf16_t;
typedef short bf16x8 __attribute__((ext_vector_type(8)));
typedef short s16x4 __attribute__((ext_vector_type(4)));
typedef float f32x4 __attribute__((ext_vector_type(4)));
typedef float f32x2 __attribute__((ext_vector_type(2)));
typedef float f32x16 __attribute__((ext_vector_type(16)));
typedef unsigned u32x4 __attribute__((ext_vector_type(4)));
typedef unsigned u32x2 __attribute__((ext_vector_type(2)));
typedef __bf16 bf16x2_t __attribute__((ext_vector_type(2)));

constexpr int BATCH = 8, SEQ = 2048, D = 1024, M = BATCH * SEQ;
constexpr int NIN = 2048;
constexpr int NE = 32, TOPK = 4, DFF = 1024;
constexpr int NSLOT = M * TOPK;
constexpr int PADROWS = NSLOT + NE * 256;
constexpr float RMS_EPS = 1e-5f;
constexpr float QSCALE = 0.125f * 1.4426950408889634f;
constexpr float LAMBDA_INIT = 0.2f;

constexpr float W_SCALE = 64.0f, H_SCALE = 8.0f, ACT_SCALE = 4.0f;
constexpr float GU_DESCALE = 1.0f / (W_SCALE * H_SCALE), DN_DESCALE = 1.0f / (W_SCALE * ACT_SCALE);
constexpr size_t MiB = 1u << 20;
constexpr size_t WS_CTL = 0, CTL_ZERO_BYTES = 1 * MiB;
constexpr size_t WS_WIN = 1 * MiB;
constexpr size_t WS_WOUT = 5 * MiB;
constexpr size_t WS_WPOOL = 7 * MiB;
constexpr size_t WS_TOKE = 8 * MiB;
constexpr size_t WS_TOKP = WS_TOKE + 256 * 1024;
constexpr size_t WS_LTOK = 9 * MiB;
constexpr size_t WS_LGATE = 11 * MiB;
constexpr size_t WS_WD = 16 * MiB;
constexpr size_t WS_WGU = 80 * MiB;
constexpr size_t WS_ACT = 208 * MiB;
constexpr size_t WS_XN = 352 * MiB;
constexpr size_t WS_QKVU = 384 * MiB;
constexpr size_t WS_MIX = 448 * MiB;
constexpr size_t WS_Y = 352 * MiB;
constexpr size_t WS_END = 496 * MiB;
constexpr int CW_CNT = 64;
constexpr int CW_BAR = 4096;

constexpr int RING_BYTES = 131072;
constexpr int LDSX_OFF = RING_BYTES;
constexpr int LDS_BYTES = 147456;

__device__ __forceinline__ unsigned pk2(float lo, float hi) { f32x2 v = {lo, hi}; bf16x2_t b = __builtin_convertvector(v, bf16x2_t); return __builtin_bit_cast(unsigned, b); }
__device__ __forceinline__ unsigned pk4_fp8(float a, float b, float c, float d) { int w = 0; w = __builtin_amdgcn_cvt_pk_fp8_f32(a, b, w, false); w = __builtin_amdgcn_cvt_pk_fp8_f32(c, d, w, true); return (unsigned)w; }
__device__ __forceinline__ float clamp448(float v) { return fminf(fmaxf(v, -448.0f), 448.0f); }
__device__ __forceinline__ float bf2f(unsigned short h) { return __uint_as_float(((unsigned)h) << 16); }
__device__ __forceinline__ float wave_sum(float v) {
#pragma unroll
    for (int o = 1; o < 64; o <<= 1) v += __shfl_xor(v, o);
    return v;
}
__device__ __forceinline__ float wave_max(float v) {
#pragma unroll
    for (int o = 1; o < 64; o <<= 1) v = fmaxf(v, __shfl_xor(v, o));
    return v;
}
__device__ __forceinline__ int wave_min_i(int v) {
#pragma unroll
    for (int o = 1; o < 64; o <<= 1) { int w = __shfl_xor(v, o); v = w < v ? w : v; }
    return v;
}

namespace pg8 {
constexpr int BM = 256, BK = 64, HALF = 128, HTB = HALF * BK * 2, STAGE_BYTES = 8 * HTB;
__device__ __forceinline__ int lds_byte(int r, int c) { const int st = (r >> 4) * 2 + (c >> 5), rr = r & 15, cc = c & 31, ob = rr * 64 + cc * 2; return st * 1024 + (ob ^ (((ob >> 9) & 1) << 5)); }
__device__ __forceinline__ void stage_rc(int b, int& R, int& C) { const int st = b / 1024, sb = b % 1024, swz = sb ^ (((sb >> 9) & 1) << 5); R = (st >> 1) * 16 + swz / 64; C = (st & 1) * 32 + (swz % 64) / 2; }
__device__ __forceinline__ int perm32(int rho) { const int n = rho >> 4, i = rho & 15; return 8 * (i >> 2) + 4 * n + (i & 3); }

struct Unit { int pm, pn, e; unsigned a00, a01, a10, a11; const char* B; };

typedef int i32x4 __attribute__((ext_vector_type(4)));
typedef int i32x8 __attribute__((ext_vector_type(8)));
__device__ __forceinline__ i32x8 cat8(bf16x8 lo, bf16x8 hi) { return __builtin_shufflevector(__builtin_bit_cast(i32x4, lo), __builtin_bit_cast(i32x4, hi), 0, 1, 2, 3, 4, 5, 6, 7); }
template <class Epi, class Sched, bool ALIGN_EPI, bool FP8>
__device__ __forceinline__ void gemm_phase(LAS unsigned char* lds, const char* A, const int Kb, const Sched& S, const Epi& E) {
    const int tid = threadIdx.x, wid = __builtin_amdgcn_readfirstlane(tid >> 6), lane = tid & 63, wr = wid >> 2, wc = wid & 3, fr = lane & 15, fq = lane >> 4;
    int nt = Kb / 128; asm volatile("" : "+s"(nt));
    int R0, C0, R1, C1; stage_rc(tid * 16, R0, C0); stage_rc(tid * 16 + 8192, R1, C1);
    unsigned voffB[2];
    { const int Rb0 = Epi::PERM ? ((R0 & ~31) + perm32(R0 & 31)) : R0, Rb1 = Epi::PERM ? ((R1 & ~31) + perm32(R1 & 31)) : R1;
      voffB[0] = (unsigned)(Rb0 * Kb + C0 * 2); voffB[1] = (unsigned)(Rb1 * Kb + C1 * 2); }
    const size_t kstep = (size_t)(BK * 2);
    const size_t hstep = (size_t)HALF * Kb;
    const unsigned ldsw = (unsigned)wid * 1024u;
    const int aoff = lds_byte(wr * 64 + fr, fq * 8), boff = lds_byte(wc * 32 + fr, fq * 8);
#define PG8_SA(b, h) (((b) * 2 + (h)) * HTB)
#define PG8_SB(b, h) ((4 + (b) * 2 + (h)) * HTB)
#define PG8_STAGEB(bufoff, gbase) do { _Pragma("unroll") for (int _i = 0; _i < 2; ++_i) \
        __builtin_amdgcn_global_load_lds((const unsigned*)((const char*)(gbase) + voffB[_i]), (LAS unsigned*)(lds + (bufoff) + ldsw + _i * 8192), 16, 0, 0); } while (0)
#define PG8_STAGEA(bufoff, kb, o0, o1) do { \
        __builtin_amdgcn_global_load_lds((const unsigned*)(A + (size_t)(o0) + (kb)), (LAS unsigned*)(lds + (bufoff) + ldsw), 16, 0, 0); \
        __builtin_amdgcn_global_load_lds((const unsigned*)(A + (size_t)(o1) + (kb)), (LAS unsigned*)(lds + (bufoff) + ldsw + 8192), 16, 0, 0); } while (0)
#define PG8_LDA(dst, b, h) do { _Pragma("unroll") for (int m = 0; m < 4; ++m) { const i32x4 lo_ = *(const LAS i32x4*)(lds + PG8_SA(b, h) + aoff + m * 2048), hi_ = *(const LAS i32x4*)(lds + PG8_SA(b, h) + aoff + m * 2048 + 1024); \
        dst[m] = __builtin_shufflevector(lo_, hi_, 0, 1, 2, 3, 4, 5, 6, 7); } } while (0)
#define PG8_LDB(dst, b, h) do { _Pragma("unroll") for (int n = 0; n < 2; ++n) { const i32x4 lo_ = *(const LAS i32x4*)(lds + PG8_SB(b, h) + boff + n * 2048), hi_ = *(const LAS i32x4*)(lds + PG8_SB(b, h) + boff + n * 2048 + 1024); \
        dst[n] = __builtin_shufflevector(lo_, hi_, 0, 1, 2, 3, 4, 5, 6, 7); } } while (0)
#define PG8_LO(v) __builtin_bit_cast(bf16x8, __builtin_shufflevector(v, v, 0, 1, 2, 3))
#define PG8_HI(v) __builtin_bit_cast(bf16x8, __builtin_shufflevector(v, v, 4, 5, 6, 7))
#define PG8_MMA(ai, bj, At, Bt) do { __builtin_amdgcn_s_setprio(1); if constexpr (FP8) { _Pragma("unroll") for (int m = 0; m < 4; ++m) _Pragma("unroll") for (int n = 0; n < 2; ++n) \
        asm volatile("s_nop 1\n\tv_mfma_f32_16x16x128_f8f6f4 %0, %1, %2, %0" : "+v"(acc[ai][bj][m][n]) : "v"(Bt[n]), "v"(At[m])); } else { \
        _Pragma("unroll") for (int m = 0; m < 4; ++m) _Pragma("unroll") for (int n = 0; n < 2; ++n) { \
        acc[ai][bj][m][n] = __builtin_amdgcn_mfma_f32_16x16x32_bf16(PG8_LO(Bt[n]), PG8_LO(At[m]), acc[ai][bj][m][n], 0, 0, 0); \
        acc[ai][bj][m][n] = __builtin_amdgcn_mfma_f32_16x16x32_bf16(PG8_HI(Bt[n]), PG8_HI(At[m]), acc[ai][bj][m][n], 0, 0, 0); } } __builtin_amdgcn_s_setprio(0); } while (0)
#define PG8_WAIT_V(n) asm volatile("s_waitcnt vmcnt(" #n ")" ::: "memory")
#define PG8_WAIT_L(n) asm volatile("s_waitcnt lgkmcnt(" #n ")" ::: "memory")
#define PG8_BAR __builtin_amdgcn_s_barrier()
#define PG8_SCHED __builtin_amdgcn_sched_barrier(0)
    Unit cur, nxt; int ui = 0;
    if (!S.next(0, cur, R0, C0, R1, C1)) return;
    f32x4 acc[2][2][4][2];
#pragma unroll
    for (int a = 0; a < 2; ++a)
#pragma unroll
        for (int b = 0; b < 2; ++b)
#pragma unroll
            for (int m = 0; m < 4; ++m)
#pragma unroll
                for (int n = 0; n < 2; ++n) acc[a][b][m][n] = (f32x4){0.f, 0.f, 0.f, 0.f};
    i32x8 At[4], B0[2], B1[2];
    const char* cB = cur.B;
    PG8_STAGEB(PG8_SB(0, 0), cB); PG8_STAGEB(PG8_SB(0, 1), cB + hstep); PG8_STAGEA(PG8_SA(0, 0), 0, cur.a00, cur.a01); PG8_STAGEA(PG8_SA(0, 1), 0, cur.a10, cur.a11);
    if (wr == 1) PG8_BAR;
    PG8_WAIT_V(2); PG8_BAR;
    PG8_STAGEB(PG8_SB(1, 0), cB + kstep); PG8_STAGEA(PG8_SA(1, 0), kstep, cur.a00, cur.a01); PG8_STAGEB(PG8_SB(1, 1), cB + hstep + kstep);
    PG8_WAIT_V(6); PG8_BAR;
    for (;;) {
        const bool has_next = S.next(ui + 1, nxt, R0, C0, R1, C1);
        if (!has_next) nxt = cur;
        const char* nB = nxt.B;
#pragma unroll 1
        for (int t = 0; t < nt; t += 2) {
            const bool last = (t == nt - 2);
            const size_t k1 = (size_t)(t + 1) * kstep;
            const size_t k2 = last ? 0 : (size_t)(t + 2) * kstep, k3 = k2 + kstep;
            const char* b2 = last ? nB : cB + (size_t)(t + 2) * kstep; const char* b3 = b2 + kstep;
            const unsigned s00 = last ? nxt.a00 : cur.a00, s01 = last ? nxt.a01 : cur.a01, s10 = last ? nxt.a10 : cur.a10, s11 = last ? nxt.a11 : cur.a11;
            PG8_LDB(B0, 0, 0); PG8_LDB(B1, 0, 1); PG8_SCHED; PG8_LDA(At, 0, 0); PG8_STAGEA(PG8_SA(1, 1), k1, cur.a10, cur.a11);
            PG8_WAIT_V(8); PG8_WAIT_L(0); PG8_BAR; PG8_MMA(0, 0, At, B0); PG8_MMA(0, 1, At, B1); PG8_BAR; PG8_SCHED;
            PG8_LDA(At, 0, 1); PG8_STAGEB(PG8_SB(0, 0), b2); PG8_STAGEB(PG8_SB(0, 1), b2 + hstep); PG8_STAGEA(PG8_SA(0, 0), k2, s00, s01);
            PG8_WAIT_V(8); PG8_WAIT_L(0); PG8_BAR; PG8_MMA(1, 0, At, B0); PG8_MMA(1, 1, At, B1); PG8_BAR; PG8_SCHED;
            PG8_LDB(B0, 1, 0); PG8_LDB(B1, 1, 1); PG8_SCHED; PG8_LDA(At, 1, 0); PG8_STAGEA(PG8_SA(0, 1), k2, s10, s11);
            PG8_WAIT_V(8); PG8_WAIT_L(0); PG8_BAR; PG8_MMA(0, 0, At, B0); PG8_MMA(0, 1, At, B1); PG8_BAR; PG8_SCHED;
            PG8_LDA(At, 1, 1); PG8_STAGEB(PG8_SB(1, 0), b3); PG8_STAGEB(PG8_SB(1, 1), b3 + hstep); PG8_STAGEA(PG8_SA(1, 0), k3, s00, s01);
            PG8_WAIT_V(8); PG8_WAIT_L(0); PG8_BAR; PG8_MMA(1, 0, At, B0); PG8_MMA(1, 1, At, B1); PG8_BAR; PG8_SCHED;
        }
        if constexpr (ALIGN_EPI) { if (wr == 0) PG8_BAR; }
        if constexpr (FP8) { PG8_SCHED; asm volatile("s_nop 15\n\ts_nop 7" ::: "memory"); PG8_SCHED; }
        E(acc, cur, wr, wc, fr, fq);
        if (!has_next) break;
#pragma unroll
        for (int a = 0; a < 2; ++a)
#pragma unroll
            for (int b = 0; b < 2; ++b)
#pragma unroll
                for (int m = 0; m < 4; ++m)
#pragma unroll
                    for (int n = 0; n < 2; ++n) acc[a][b][m][n] = (f32x4){0.f, 0.f, 0.f, 0.f};
        cur = nxt; cB = nB; ++ui;
        if constexpr (ALIGN_EPI) { if (wr == 1) PG8_BAR; }
    }
    PG8_WAIT_V(0);
    if constexpr (!ALIGN_EPI) { if (wr == 0) PG8_BAR; }
    PG8_BAR;
#undef PG8_SA
#undef PG8_SB
#undef PG8_STAGEA
#undef PG8_STAGEB
#undef PG8_LDA
#undef PG8_LDB
#undef PG8_LO
#undef PG8_HI
#undef PG8_MMA
#undef PG8_WAIT_V
#undef PG8_WAIT_L
#undef PG8_BAR
#undef PG8_SCHED
}

struct DenseSched {
    int nM, nN, nwg, G, c, Kb, dup; const char* Bt;
    __device__ __forceinline__ void init(int Mr, int N, int Kb_, int G_, int c_, const void* Bt_, int dup_) { nM = Mr / BM; nN = N / BM; nwg = nM * nN; G = G_; c = c_; Kb = Kb_; Bt = (const char*)Bt_; dup = dup_; }
    __device__ __forceinline__ bool next(int i, Unit& u, int R0, int C0, int R1, int C1) const {
        const long L = (long)(i / dup) * G + c; if (L >= nwg) return false;
        int wgid = (int)L; { const int q = nwg / 8, r = nwg % 8, xcd = wgid % 8, off = wgid / 8; wgid = (xcd < r ? xcd * (q + 1) : r * (q + 1) + (xcd - r) * q) + off; }
        const int WGM = 8, nig = WGM * nN, gid = wgid / nig, fm = gid * WGM, gsz = (nM - fm) < WGM ? (nM - fm) : WGM;
        u.pm = fm + ((wgid % nig) % gsz); u.pn = (wgid % nig) / gsz; u.e = 0;
        const unsigned rb = (unsigned)u.pm * 256u;
        u.a00 = (rb + R0) * Kb + C0 * 2; u.a01 = (rb + R1) * Kb + C1 * 2; u.a10 = (rb + 128 + R0) * Kb + C0 * 2; u.a11 = (rb + 128 + R1) * Kb + C1 * 2;
        u.B = Bt + (size_t)u.pn * 256 * Kb; return true;
    }
};
struct MoeSched {
    const LAS int* tp; const LAS int* cnt; int NT; int xcd, j; int Kb; const char* W; size_t wstride; const int* ltok; bool gather;
    __device__ __forceinline__ int rd(const LAS int* p) const { return __builtin_amdgcn_readfirstlane(*p); }
    __device__ __forceinline__ bool next(int i, Unit& u, int R0, int C0, int R1, int C1) const {
        const int U = rd(tp + NE) * NT; const int lo = (int)(((long)xcd * U) / 8), hi = (int)(((long)(xcd + 1) * U) / 8);
        const int L = lo + i * 32 + j; if (L >= hi) return false;
        int e = 0;
        for (int q = 1; q < NE; ++q) e = (L >= rd(tp + q) * NT) ? q : e;
        const int tpe = rd(tp + e), nte = rd(tp + e + 1) - tpe, r = L - tpe * NT, pn = r / nte, mt = r % nte;
        u.e = e; u.pn = pn; u.pm = tpe + mt;
        if (gather) {
            const int ce = rd(cnt + e); const int* lt = ltok + (size_t)e * M;
            const int i00 = mt * 256 + R0, i01 = mt * 256 + R1, i10 = i00 + 128, i11 = i01 + 128;
            const unsigned t00 = i00 < ce ? (unsigned)lt[i00] : 0u, t01 = i01 < ce ? (unsigned)lt[i01] : 0u, t10 = i10 < ce ? (unsigned)lt[i10] : 0u, t11 = i11 < ce ? (unsigned)lt[i11] : 0u;
            u.a00 = t00 * Kb + C0 * 2; u.a01 = t01 * Kb + C1 * 2; u.a10 = t10 * Kb + C0 * 2; u.a11 = t11 * Kb + C1 * 2;
        } else {
            const unsigned rb = (unsigned)u.pm * 256u;
            u.a00 = (rb + R0) * Kb + C0 * 2; u.a01 = (rb + R1) * Kb + C1 * 2; u.a10 = (rb + 128 + R0) * Kb + C0 * 2; u.a11 = (rb + 128 + R1) * Kb + C1 * 2;
        }
        u.B = W + (size_t)e * wstride + (size_t)pn * 256 * Kb; return true;
    }
};

struct EpiQkvu {
    static constexpr bool PERM = true; bf16_t* O;
    __device__ __forceinline__ void operator()(const f32x4 (&acc)[2][2][4][2], const Unit& u, int wr, int wc, int fr, int fq) const {
        const int row0 = u.pm * BM + wr * 64 + fr, col0 = u.pn * BM + wc * 32 + 8 * fq; const float sc = (u.pn < 2) ? QSCALE : 1.f;
#pragma unroll
        for (int ai = 0; ai < 2; ++ai)
#pragma unroll
            for (int m = 0; m < 4; ++m) { bf16_t* rowp = O + (size_t)(row0 + ai * HALF + m * 16) * NIN + col0;
#pragma unroll
                for (int bj = 0; bj < 2; ++bj) { const f32x4 v0 = acc[ai][bj][m][0] * sc, v1 = acc[ai][bj][m][1] * sc;
                    u32x4 w; w.x = pk2(v0[0], v0[1]); w.y = pk2(v0[2], v0[3]); w.z = pk2(v1[0], v1[1]); w.w = pk2(v1[2], v1[3]);
                    *(u32x4*)(rowp + bj * HALF) = w; } }
    }
};
struct EpiResF32 {
    static constexpr bool PERM = false; const float* base; float* out;
    __device__ __forceinline__ void operator()(const f32x4 (&acc)[2][2][4][2], const Unit& u, int wr, int wc, int fr, int fq) const {
        const int col0 = u.pn * BM + wc * 32 + 4 * fq;
#pragma unroll
        for (int ai = 0; ai < 2; ++ai)
#pragma unroll
            for (int m = 0; m < 4; ++m) { const size_t off = (size_t)(u.pm * BM + ai * HALF + wr * 64 + m * 16 + fr) * D + col0;
#pragma unroll
                for (int bj = 0; bj < 2; ++bj)
#pragma unroll
                    for (int n = 0; n < 2; ++n) { const f32x4 bs = *(const f32x4*)(base + off + bj * HALF + n * 16); *(f32x4*)(out + off + bj * HALF + n * 16) = bs + acc[ai][bj][m][n]; } }
    }
};
struct EpiSwiglu {
    static constexpr bool PERM = true; unsigned char* ACT; const float* bg; const float* bu;
    __device__ __forceinline__ void operator()(const f32x4 (&acc)[2][2][4][2], const Unit& u, int wr, int wc, int fr, int fq) const {
        const int row0 = u.pm * BM + wr * 64 + fr, col0 = u.pn * 128 + wc * 32 + 8 * fq;
        f32x4 g4[2], u4[2];
#pragma unroll
        for (int n = 0; n < 2; ++n) { g4[n] = *(const f32x4*)(bg + (size_t)u.e * DFF + col0 + 4 * n); u4[n] = *(const f32x4*)(bu + (size_t)u.e * DFF + col0 + 4 * n); }
#pragma unroll
        for (int ai = 0; ai < 2; ++ai)
#pragma unroll
            for (int m = 0; m < 4; ++m) { float a[8];
#pragma unroll
                for (int n = 0; n < 2; ++n)
#pragma unroll
                    for (int j = 0; j < 4; ++j) { const float g = fminf(acc[ai][0][m][n][j] * GU_DESCALE + g4[n][j], 7.0f); const float up = fminf(fmaxf(acc[ai][1][m][n][j] * GU_DESCALE + u4[n][j], -7.0f), 7.0f);
                        const float sg = __builtin_amdgcn_rcpf(1.0f + __builtin_amdgcn_exp2f(-1.702f * 1.4426950408889634f * g)); a[n * 4 + j] = g * sg * (up + 1.0f) * ACT_SCALE; }
                u32x2 w; w.x = pk4_fp8(a[0], a[1], a[2], a[3]); w.y = pk4_fp8(a[4], a[5], a[6], a[7]);
                *(u32x2*)(ACT + (size_t)(row0 + ai * HALF + m * 16) * DFF + col0) = w; }
    }
};
struct EpiDown {
    static constexpr bool PERM = true; bf16_t* Y; const float* bd; const float* lgate; const LAS int* tp;
    __device__ __forceinline__ void operator()(const f32x4 (&acc)[2][2][4][2], const Unit& u, int wr, int wc, int fr, int fq) const {
        const int mt = u.pm - tp[u.e]; const int row0 = u.pm * BM + wr * 64 + fr, col0 = u.pn * BM + wc * 32 + 8 * fq;
        const float* lg = lgate + (size_t)u.e * M + mt * 256 + wr * 64 + fr;
        f32x4 bv[2][2];
#pragma unroll
        for (int bj = 0; bj < 2; ++bj)
#pragma unroll
            for (int n = 0; n < 2; ++n) bv[bj][n] = *(const f32x4*)(bd + (size_t)u.e * D + col0 + bj * HALF + 4 * n);
#pragma unroll
        for (int ai = 0; ai < 2; ++ai)
#pragma unroll
            for (int m = 0; m < 4; ++m) { const float gt = lg[ai * HALF + m * 16]; bf16_t* rowp = Y + (size_t)(row0 + ai * HALF + m * 16) * D + col0;
#pragma unroll
                for (int bj = 0; bj < 2; ++bj) { const f32x4 v0 = (acc[ai][bj][m][0] * DN_DESCALE + bv[bj][0]) * gt, v1 = (acc[ai][bj][m][1] * DN_DESCALE + bv[bj][1]) * gt;
                    u32x4 w; w.x = pk2(v0[0], v0[1]); w.y = pk2(v0[2], v0[3]); w.z = pk2(v1[0], v1[1]); w.w = pk2(v1[2], v1[3]);
                    *(u32x4*)(rowp + bj * HALF) = w; } }
    }
};
}

namespace att {
__device__ __forceinline__ int crow(int r, int hi) { return (r & 3) + 8 * (r >> 2) + 4 * hi; }
__device__ __forceinline__ s16x4 vtr(const LAS unsigned char* p) { typedef short v4 __attribute__((ext_vector_type(4))); return __builtin_bit_cast(s16x4, __builtin_amdgcn_ds_read_tr16_b64_v4i16((LAS v4*)p)); }

__device__ __forceinline__ void attn_unit(int b, int h, int qb, const bf16_t* QKVU, bf16_t* MIX, LAS unsigned char* lds, float lam, const float* subln_g) {
    const int tid = threadIdx.x, lane = tid & 63, r32 = lane & 31, hi = lane >> 5; const int wid = __builtin_amdgcn_readfirstlane(tid >> 6);
    const int map = wid >> 2, wq = wid & 3;
    const long rowbase = (long)b * SEQ; const int q0 = qb * 128;
    const int NT = 2 * qb + 2;
    const bf16_t* Qp = QKVU + (size_t)(rowbase + q0 + wq * 32 + r32) * NIN + h * 128 + map * 64 + hi * 8;
    bf16x8 qr[4];
#pragma unroll
    for (int d0 = 0; d0 < 4; ++d0) qr[d0] = *(const bf16x8*)(Qp + d0 * 16);
    const bf16_t* ksrc[2]; const bf16_t* vsrc[2];
#pragma unroll
    for (int i = 0; i < 2; ++i) { const int p = 2 * wid + i;
        ksrc[i] = QKVU + (size_t)(rowbase + lane) * NIN + 512 + h * 128 + (p >> 3) * 64 + (p & 7) * 8;
        vsrc[i] = QKVU + (size_t)(rowbase + 16 * (p & 3) + (lane >> 2)) * NIN + 1024 + h * 128 + (p >> 2) * 32 + (lane & 3) * 8; }
#define ATT_DMA(t, buf) do { _Pragma("unroll") for (int _i = 0; _i < 2; ++_i) { \
        __builtin_amdgcn_global_load_lds((const unsigned*)(ksrc[_i] + (size_t)(t) * 64 * NIN), (LAS unsigned*)(lds + (buf) * 32768 + (2 * wid + _i) * 1024), 16, 0, 0); \
        __builtin_amdgcn_global_load_lds((const unsigned*)(vsrc[_i] + (size_t)(t) * 64 * NIN), (LAS unsigned*)(lds + (buf) * 32768 + 16384 + (2 * wid + _i) * 1024), 16, 0, 0); } } while (0)
    float m_run = -INFINITY, l_run = 0.f;
    f32x16 o[4];
#pragma unroll
    for (int d0 = 0; d0 < 4; ++d0) o[d0] = f32x16{};
    const int qabs = q0 + wq * 32 + r32;
    ATT_DMA(0, 0);
    for (int t = 0; t < NT; ++t) {
        __syncthreads();
        if (t + 1 < NT) ATT_DMA(t + 1, (t + 1) & 1);
        if (64 * t <= q0 + wq * 32 + 31) {
            const LAS unsigned char* Kb = lds + (t & 1) * 32768 + map * 8192 + hi * 1024 + r32 * 16;
            const LAS unsigned char* Vb = lds + (t & 1) * 32768 + 16384 + ((lane >> 4) & 1) * 32 + (lane & 3) * 8 + (4 * hi + ((lane & 15) >> 2)) * 64;
            f32x16 p0 = f32x16{}, p1 = f32x16{};
#pragma unroll
            for (int d0 = 0; d0 < 4; ++d0) {
                const bf16x8 k0 = *(const LAS bf16x8*)(Kb + d0 * 2048), k1 = *(const LAS bf16x8*)(Kb + d0 * 2048 + 512);
                p0 = __builtin_amdgcn_mfma_f32_32x32x16_bf16(k0, qr[d0], p0, 0, 0, 0);
                p1 = __builtin_amdgcn_mfma_f32_32x32x16_bf16(k1, qr[d0], p1, 0, 0, 0);
            }
            if (t >= NT - 2) {
#pragma unroll
                for (int r = 0; r < 16; ++r) { const int kv = 64 * t + crow(r, hi); if (kv > qabs) p0[r] = -INFINITY; if (kv + 32 > qabs) p1[r] = -INFINITY; }
            }
            float rm = fmaxf(p0[0], p1[0]);
#pragma unroll
            for (int r = 1; r < 16; ++r) rm = fmaxf(rm, fmaxf(p0[r], p1[r]));
            { auto rr = __builtin_amdgcn_permlane32_swap(__float_as_uint(rm), __float_as_uint(rm), false, false); rm = fmaxf(__uint_as_float(rr[0]), __uint_as_float(rr[1])); }
            const float mnew = fmaxf(m_run, rm);
            const float f = __builtin_amdgcn_exp2f(m_run - mnew);
            m_run = mnew;
            float ls = 0.f;
#pragma unroll
            for (int r = 0; r < 16; ++r) { p0[r] = __builtin_amdgcn_exp2f(p0[r] - mnew); p1[r] = __builtin_amdgcn_exp2f(p1[r] - mnew); ls += p0[r] + p1[r]; }
            l_run = l_run * f + ls;
            if (!__all(f == 1.0f)) {
#pragma unroll
                for (int d0 = 0; d0 < 4; ++d0)
#pragma unroll
                    for (int r = 0; r < 16; ++r) o[d0][r] *= f;
            }
            bf16x8 pa[4];
#pragma unroll
            for (int s = 0; s < 2; ++s) {
                u32x4 w0, w1;
                w0.x = pk2(p0[8 * s + 0], p0[8 * s + 1]); w0.y = pk2(p0[8 * s + 2], p0[8 * s + 3]); w0.z = pk2(p0[8 * s + 4], p0[8 * s + 5]); w0.w = pk2(p0[8 * s + 6], p0[8 * s + 7]);
                w1.x = pk2(p1[8 * s + 0], p1[8 * s + 1]); w1.y = pk2(p1[8 * s + 2], p1[8 * s + 3]); w1.z = pk2(p1[8 * s + 4], p1[8 * s + 5]); w1.w = pk2(p1[8 * s + 6], p1[8 * s + 7]);
                pa[s] = __builtin_bit_cast(bf16x8, w0); pa[2 + s] = __builtin_bit_cast(bf16x8, w1);
            }
#pragma unroll
            for (int d0 = 0; d0 < 4; ++d0) {
#pragma unroll
                for (int ks = 0; ks < 4; ++ks) {
                    const s16x4 lo = vtr(Vb + (d0 * 4 + ks) * 1024), hh = vtr(Vb + (d0 * 4 + ks) * 1024 + 512);
                    const bf16x8 vf = (bf16x8){lo[0], lo[1], lo[2], lo[3], hh[0], hh[1], hh[2], hh[3]};
                    o[d0] = __builtin_amdgcn_mfma_f32_32x32x16_bf16(vf, pa[ks], o[d0], 0, 0, 0);
                }
            }
        }
    }
#undef ATT_DMA
    { auto rr = __builtin_amdgcn_permlane32_swap(__float_as_uint(l_run), __float_as_uint(l_run), false, false); l_run = __uint_as_float(rr[0]) + __uint_as_float(rr[1]); }
    const float rl = 1.0f / l_run;
    __syncthreads();
    LAS float* xs = (LAS float*)lds + wq * 4096 + lane;
    if (map == 1) {
#pragma unroll
        for (int d0 = 0; d0 < 4; ++d0)
#pragma unroll
            for (int r = 0; r < 16; ++r) xs[(d0 * 16 + r) * 64] = o[d0][r] * rl;
    }
    __syncthreads();
    if (map == 0) {
        float ss = 0.f;
#pragma unroll
        for (int d0 = 0; d0 < 4; ++d0)
#pragma unroll
            for (int r = 0; r < 16; ++r) { const float a = o[d0][r] * rl - lam * xs[(d0 * 16 + r) * 64]; o[d0][r] = a; ss += a * a; }
        { auto rr = __builtin_amdgcn_permlane32_swap(__float_as_uint(ss), __float_as_uint(ss), false, false); ss = __uint_as_float(rr[0]) + __uint_as_float(rr[1]); }
        const float rs = rsqrtf(ss * (1.0f / 128.0f) + RMS_EPS) * (1.0f - LAMBDA_INIT);
        bf16_t* Op = MIX + (size_t)(rowbase + qabs) * D + h * 128 + 4 * hi;
#pragma unroll
        for (int d0 = 0; d0 < 4; ++d0)
#pragma unroll
            for (int g = 0; g < 4; ++g) { const int dv = d0 * 32 + 8 * g + 4 * hi; const f32x4 sg = *(const f32x4*)(subln_g + dv);
                u32x2 w; w.x = pk2(o[d0][4 * g + 0] * rs * sg[0], o[d0][4 * g + 1] * rs * sg[1]); w.y = pk2(o[d0][4 * g + 2] * rs * sg[2], o[d0][4 * g + 3] * rs * sg[3]);
                *(u32x2*)(Op + d0 * 32 + 8 * g) = w; }
    }
    __syncthreads();
}
}

__device__ __forceinline__ void pool_unit(int tile, int g, const bf16_t* QKVU, const bf16_t* WPt, const float* b_pool, const float* pool_scale, bf16_t* MIX, LAS unsigned char* lds) {
    const int tid = threadIdx.x, lane = tid & 63, fr = lane & 15, fq = lane >> 4; const int wid = __builtin_amdgcn_readfirstlane(tid >> 6);
    const int t0 = tile * 128, s0 = t0 % SEQ, w = 2 << g;
    LAS float* U = (LAS float*)lds;
    LAS bf16_t* Z = (LAS bf16_t*)(lds + 144 * 132 * 4);
    for (int it = tid; it < 144 * 16; it += 512) { const int r = it >> 4, c8 = (it & 15) * 8; const int trow = t0 - 16 + r;
        f32x4 lo = {0.f, 0.f, 0.f, 0.f}, hi4 = {0.f, 0.f, 0.f, 0.f};
        if (s0 + r - 16 >= 0) { const u32x4 v = *(const u32x4*)(QKVU + (size_t)trow * NIN + 1536 + g * 128 + c8);
            lo = (f32x4){__uint_as_float(v.x << 16), __uint_as_float(v.x & 0xffff0000u), __uint_as_float(v.y << 16), __uint_as_float(v.y & 0xffff0000u)};
            hi4 = (f32x4){__uint_as_float(v.z << 16), __uint_as_float(v.z & 0xffff0000u), __uint_as_float(v.w << 16), __uint_as_float(v.w & 0xffff0000u)}; }
        *(LAS f32x4*)(U + r * 132 + c8) = lo; *(LAS f32x4*)(U + r * 132 + c8 + 4) = hi4; }
    __syncthreads();
    for (int it = tid; it < 128 * 64; it += 512) { const int r = it >> 6, c2 = (it & 63) * 2; float a0 = 0.f, a1 = 0.f;
        for (int j = 0; j < w; ++j) { const f32x2 v = *(const LAS f32x2*)(U + (16 + r - j) * 132 + c2); a0 += v.x; a1 += v.y; }
        const int pos1 = s0 + r + 1; const float inv = 1.0f / (float)(pos1 < w ? pos1 : w); const f32x2 uu = *(const LAS f32x2*)(U + (16 + r) * 132 + c2);
        *(LAS unsigned*)(Z + r * 136 + c2) = pk2(a0 * inv - uu.x, a1 * inv - uu.y); }
    __syncthreads();
    f32x4 acc[8];
#pragma unroll
    for (int nb = 0; nb < 8; ++nb) acc[nb] = (f32x4){0.f, 0.f, 0.f, 0.f};
#pragma unroll
    for (int ks = 0; ks < 4; ++ks) { const bf16x8 zf = *(const LAS bf16x8*)(Z + (wid * 16 + fr) * 136 + ks * 32 + fq * 8);
#pragma unroll
        for (int nb = 0; nb < 8; ++nb) { const bf16x8 wf = *(const bf16x8*)(WPt + (size_t)g * 16384 + (nb * 16 + fr) * 128 + ks * 32 + fq * 8); acc[nb] = __builtin_amdgcn_mfma_f32_16x16x32_bf16(wf, zf, acc[nb], 0, 0, 0); } }
    bf16_t* Op = MIX + (size_t)(t0 + wid * 16 + fr) * D + 512 + g * 128;
#pragma unroll
    for (int nb = 0; nb < 8; ++nb) { const int c = nb * 16 + 4 * fq; const f32x4 bb = *(const f32x4*)(b_pool + g * 128 + c), ps = *(const f32x4*)(pool_scale + g * 128 + c); const f32x4 v = (acc[nb] + bb) * ps;
        u32x2 wv; wv.x = pk2(v[0], v[1]); wv.y = pk2(v[2], v[3]); *(u32x2*)(Op + c) = wv; }
    __syncthreads();
}

__device__ __forceinline__ void transpose_item(const float* W, int N, int k0, int n0, bf16_t* WT, int K, int drow0, LAS float* scr, int lane) {
#pragma unroll 8
    for (int i = 0; i < 32; ++i) { const int kk = 2 * i + (lane >> 5); scr[kk * 33 + (lane & 31)] = W[(size_t)(k0 + kk) * N + n0 + (lane & 31)]; }
    asm volatile("s_waitcnt lgkmcnt(0)" ::: "memory");
    const int c = lane & 7;
#pragma unroll
    for (int j = 0; j < 4; ++j) { const int n = (lane >> 3) + 8 * j; const LAS float* s = scr + (8 * c) * 33 + n;
        u32x4 o; o.x = pk2(s[0 * 33], s[1 * 33]); o.y = pk2(s[2 * 33], s[3 * 33]); o.z = pk2(s[4 * 33], s[5 * 33]); o.w = pk2(s[6 * 33], s[7 * 33]);
        *(u32x4*)(WT + (size_t)(drow0 + n) * K + k0 + 8 * c) = o; }
    asm volatile("s_waitcnt lgkmcnt(0)" ::: "memory");
}
__device__ __forceinline__ void transpose_item_fp8(const float* W, int N, int k0, int n0, unsigned char* WT, int K, int drow0, LAS float* scr, int lane) {
#pragma unroll 8
    for (int i = 0; i < 32; ++i) { const int kk = 2 * i + (lane >> 5); scr[kk * 33 + (lane & 31)] = W[(size_t)(k0 + kk) * N + n0 + (lane & 31)]; }
    asm volatile("s_waitcnt lgkmcnt(0)" ::: "memory");
    const int c = lane & 3;
#pragma unroll
    for (int j = 0; j < 2; ++j) { const int n = (lane >> 2) + 16 * j; const LAS float* s = scr + (16 * c) * 33 + n;
        float v[16];
#pragma unroll
        for (int i = 0; i < 16; ++i) v[i] = clamp448(s[i * 33] * W_SCALE);
        u32x4 o; o.x = pk4_fp8(v[0], v[1], v[2], v[3]); o.y = pk4_fp8(v[4], v[5], v[6], v[7]); o.z = pk4_fp8(v[8], v[9], v[10], v[11]); o.w = pk4_fp8(v[12], v[13], v[14], v[15]);
        *(u32x4*)(WT + (size_t)(drow0 + n) * K + k0 + 16 * c) = o; }
    asm volatile("s_waitcnt lgkmcnt(0)" ::: "memory");
}
__device__ __forceinline__ void rms_row_to_bf16(const float* xrow, const float* g, bf16_t* orow, int lane) {
    const f32x4* xr = (const f32x4*)xrow + lane; const f32x4* gr = (const f32x4*)g + lane;
    f32x4 v[4]; float s = 0.f;
#pragma unroll
    for (int j = 0; j < 4; ++j) { v[j] = xr[64 * j]; s += (v[j].x * v[j].x + v[j].y * v[j].y) + (v[j].z * v[j].z + v[j].w * v[j].w); }
    const float rstd = rsqrtf(wave_sum(s) * (1.f / D) + RMS_EPS);
    u32x2* o8 = (u32x2*)orow + lane;
#pragma unroll
    for (int j = 0; j < 4; ++j) { const f32x4 gg = gr[64 * j]; u32x2 w; w.x = pk2(v[j].x * rstd * gg.x, v[j].y * rstd * gg.y); w.y = pk2(v[j].z * rstd * gg.z, v[j].w * rstd * gg.w); o8[64 * j] = w; }
}


#define XB_TMO      128
#define XB_XCNT(j)  (256  + 64 * (j))
#define XB_XSUB(j)  (1280 + 64 * (j))
#define XB_XGEN(j)  (2304 + 64 * (j))
#define XB_TOP      3328
#define XB_TOPGEN   3392
#define XCD_BAR_WORDS 3456
#define XB_SPIN_CAP (1u << 18)
__device__ __forceinline__ unsigned xb_ld(unsigned* p)              { return __hip_atomic_load(p, __ATOMIC_RELAXED, __HIP_MEMORY_SCOPE_AGENT); }
__device__ __forceinline__ unsigned xb_add(unsigned* p, unsigned v) { return __hip_atomic_fetch_add(p, v, __ATOMIC_RELAXED, __HIP_MEMORY_SCOPE_AGENT); }
__device__ __forceinline__ unsigned xb_xcc_id() { return (unsigned)__builtin_amdgcn_s_getreg((3 << 11) | 20) & 0xFu; }
#define XB_SPIN(cond, bar) do { unsigned _sp = 0; while (cond) { __builtin_amdgcn_s_sleep(1); \
    if ((++_sp & 255u) == 0u) { if (xb_ld(&(bar)[XB_TMO])) break; if (_sp > XB_SPIN_CAP) { atomicAdd(&(bar)[XB_TMO], 1u); break; } } } } while (0)
struct XcdBarrier { unsigned* bar; unsigned x; volatile LAS unsigned* st; };
__device__ __forceinline__ XcdBarrier xcd_barrier_post(unsigned* bar, volatile LAS unsigned* st) {
    XcdBarrier b; b.bar = bar; b.x = xb_xcc_id(); b.st = st;
    if (threadIdx.x == 0) (void)xb_add(&bar[XB_XCNT(b.x)], 1u);
    return b;
}
__device__ __forceinline__ void xcd_barrier_complete(unsigned* bar, unsigned x, unsigned& nloc, unsigned& nx) {
    const unsigned G = gridDim.x * gridDim.y * gridDim.z;
    unsigned sum, cnt, mine, sp = 0u;
    for (;;) {
        sum = 0u; cnt = 0u; mine = 0u;
#pragma unroll
        for (unsigned j = 0; j < 16; ++j) { const unsigned c = xb_ld(&bar[XB_XCNT(j)]); sum += c; cnt += (c > 0u) ? 1u : 0u; mine = (j == x) ? c : mine; }
        if (sum == G) break;
        __builtin_amdgcn_s_sleep(1);
        if ((++sp & 255u) == 0u) { if (xb_ld(&bar[XB_TMO])) break; if (sp > XB_SPIN_CAP) { atomicAdd(&bar[XB_TMO], 1u); break; } }
    }
    nloc = mine > 0u ? mine : 1u; nx = cnt > 0u ? cnt : 1u;
}
__device__ __forceinline__ void xcd_barrier(const XcdBarrier& b) {
    asm volatile("s_waitcnt vmcnt(0)" ::: "memory");
    __syncthreads();
    if (threadIdx.x == 0) {
        unsigned* bar = b.bar;
        __builtin_amdgcn_s_waitcnt(0);
        unsigned nloc = b.st[0], nx = b.st[1];
        if (nloc == 0u) { xcd_barrier_complete(bar, b.x, nloc, nx); b.st[0] = nloc; b.st[1] = nx; }
        const unsigned old = xb_add(&bar[XB_XSUB(b.x)], 1u);
        const unsigned gen = old / nloc;
        if (old + 1u == (gen + 1u) * nloc) {
            __builtin_amdgcn_fence(__ATOMIC_RELEASE, "agent");
            asm volatile("s_waitcnt vmcnt(0)" ::: "memory");
            const unsigned og = xb_add(&bar[XB_TOP], 1u);
            const unsigned tg = og / nx;
            if (og + 1u == (tg + 1u) * nx) xb_add(&bar[XB_TOPGEN], 1u);
            else XB_SPIN(xb_ld(&bar[XB_TOPGEN]) == tg, bar);
            __builtin_amdgcn_fence(__ATOMIC_ACQUIRE, "agent");
            xb_add(&bar[XB_XGEN(b.x)], 1u);
            asm volatile("s_waitcnt vmcnt(0)" ::: "memory");
        } else {
            XB_SPIN(xb_ld(&bar[XB_XGEN(b.x)]) == gen, bar);
            __builtin_amdgcn_fence(__ATOMIC_ACQUIRE, "agent");
            asm volatile("s_waitcnt vmcnt(0)" ::: "memory");
        }
    }
    __syncthreads();
}

struct Args {
    const float *x, *norm1_g, *w_in, *lq1, *lk1, *lq2, *lk2, *subln_g, *w_pool, *b_pool, *pool_scale, *w_out, *norm2_g, *router_w, *router_b,
                *w_gate, *b_gate, *w_up, *b_up, *w_down, *b_down, *final_g;
    float* out; unsigned char* ws; int ph_lo, ph_hi;
};

__global__ void __launch_bounds__(512, 2) mk_fwd(Args a) {
    extern __shared__ __attribute__((aligned(16))) unsigned char lds_raw[];
    LAS unsigned char* lds = (LAS unsigned char*)lds_raw;
    const int tid = threadIdx.x, lane = tid & 63; const int wave = __builtin_amdgcn_readfirstlane(tid >> 6);
    const int G = gridDim.x, bx = blockIdx.x; const int vcu = (G % 8 == 0) ? (bx % 8) * (G / 8) + bx / 8 : bx;
    unsigned char* ws = a.ws;
    unsigned* ctl = (unsigned*)(ws + WS_CTL);
    bf16_t* WIN = (bf16_t*)(ws + WS_WIN); bf16_t* WOUT = (bf16_t*)(ws + WS_WOUT); bf16_t* WPOOL = (bf16_t*)(ws + WS_WPOOL);
    bf16_t* WD = (bf16_t*)(ws + WS_WD); bf16_t* WGU = (bf16_t*)(ws + WS_WGU); bf16_t* ACT = (bf16_t*)(ws + WS_ACT);
    bf16_t* XN = (bf16_t*)(ws + WS_XN); bf16_t* QKVU = (bf16_t*)(ws + WS_QKVU); bf16_t* MIX = (bf16_t*)(ws + WS_MIX); bf16_t* Y = (bf16_t*)(ws + WS_Y);
    int* TOKE = (int*)(ws + WS_TOKE); int* TOKP = (int*)(ws + WS_TOKP); int* LTOK = (int*)(ws + WS_LTOK); float* LGATE = (float*)(ws + WS_LGATE);
    float* x1 = a.out;
    LAS int* ldsx = (LAS int*)(lds + LDSX_OFF);
    const int lo = a.ph_lo, hi = a.ph_hi;
#define IN(k) (lo <= (k) && (k) < hi)
#if MK_N_LAUNCHES == 1
    if (tid < 2) ldsx[248 + tid] = 0;
    __syncthreads();
    const XcdBarrier gbar = xcd_barrier_post(ctl + CW_BAR, (volatile LAS unsigned*)(ldsx + 248));
#define GRID_BAR() do { xcd_barrier(gbar); } while (0)
#else
#define GRID_BAR() do { } while (0)
#endif
    const int gw = vcu * 8 + wave, NGW = G * 8;

    if (IN(0)) {
      for (int rep = 0; rep < REP0; ++rep) {
        LAS float* scr = (LAS float*)(lds + wave * 16384);
        constexpr int I_EXP = 96 * 512, I_IN = 16 * 64, I_OUT = 512, I_POOL = 32, NITEMS = I_EXP + I_IN + I_OUT + I_POOL;
        for (int it = gw; it < NITEMS; it += NGW) {
            int r = it;
            if (r < I_EXP) { const int mi = r >> 9, e = mi / 3, which = mi % 3, q = r & 511, kb = q >> 5, nb = q & 31, n0 = nb * 32;
                if (which == 2) transpose_item_fp8(a.w_down + (size_t)e * D * D, D, kb * 64, n0, (unsigned char*)WD + (size_t)e * D * D, D, n0, scr, lane);
                else transpose_item_fp8((which == 0 ? a.w_gate : a.w_up) + (size_t)e * D * D, D, kb * 64, n0, (unsigned char*)WGU + (size_t)e * 2048 * D, D, (n0 >> 7) * 256 + which * 128 + (n0 & 127), scr, lane);
                continue; }
            r -= I_EXP;
            if (r < I_IN) { const int kb = r >> 6, nb = r & 63; transpose_item(a.w_in, NIN, kb * 64, nb * 32, WIN, D, nb * 32, scr, lane); continue; }
            r -= I_IN;
            if (r < I_OUT) { const int kb = r >> 5, nb = r & 31; transpose_item(a.w_out, D, kb * 64, nb * 32, WOUT, D, nb * 32, scr, lane); continue; }
            r -= I_OUT;
            { const int g = r >> 3, q = r & 7, kb = q >> 2, nb = q & 3; transpose_item(a.w_pool + (size_t)g * 16384, 128, kb * 64, nb * 32, WPOOL + (size_t)g * 16384, 128, nb * 32, scr, lane); }
        }
        for (int m = gw; m < M; m += NGW) rms_row_to_bf16(a.x + (size_t)m * D, a.norm1_g, XN + (size_t)m * D, lane);
      }
        if (IN(1)) GRID_BAR();
    }

    if (IN(1)) {
        pg8::DenseSched S; S.init(M, NIN, D * 2, G, bx, WIN, REP1);
        pg8::EpiQkvu E{QKVU};
        pg8::gemm_phase<pg8::EpiQkvu, pg8::DenseSched, true, false>(lds, (const char*)XN, D * 2, S, E);
        if (IN(2)) GRID_BAR();
    }

    if (IN(2)) {
        float s1 = 0.f, s2 = 0.f;
        for (int i = 0; i < 64; ++i) { s1 += a.lq1[i] * a.lk1[i]; s2 += a.lq2[i] * a.lk2[i]; }
        const float lam = __expf(s1) - __expf(s2) + LAMBDA_INIT;
        for (int rep = 0; rep < REP2; ++rep) for (int p = vcu; p < 256; p += G) { const int bh = p >> 3, j = p & 7;
            att::attn_unit(bh >> 2, bh & 3, 15 - j, QKVU, MIX, lds, lam, a.subln_g);
            att::attn_unit(bh >> 2, bh & 3, j, QKVU, MIX, lds, lam, a.subln_g); }
        for (int rep = 0; rep < REPPOOL; ++rep) for (int u = vcu; u < 512; u += G) pool_unit(u >> 2, u & 3, QKVU, WPOOL, a.b_pool, a.pool_scale, MIX, lds);
        if (IN(3)) GRID_BAR();
    }

    if (IN(3)) {
        pg8::DenseSched S; S.init(M, D, D * 2, G, bx, WOUT, REP3);
        pg8::EpiResF32 E{a.x, x1};
        pg8::gemm_phase<pg8::EpiResF32, pg8::DenseSched, true, false>(lds, (const char*)MIX, D * 2, S, E);
        if (IN(4)) GRID_BAR();
    }

    if (IN(4)) {
      for (int rep = 0; rep < REP4; ++rep) {
        const bool dummy = rep + 1 < REP4;
        unsigned* cntp = ctl + CW_CNT + (dummy ? 32 : 0);
        int* LTOKw = dummy ? (int*)(ws + WS_ACT) : LTOK; float* LGATEw = dummy ? (float*)(ws + WS_ACT + 2 * MiB) : LGATE;
        int* TOKEw = dummy ? (int*)(ws + WS_ACT + 4 * MiB) : TOKE; int* TOKPw = dummy ? (int*)(ws + WS_ACT + 5 * MiB) : TOKP;
        __syncthreads();
        for (int it = tid; it < 1024 * 8; it += 512) { const int c = it >> 3, ch = it & 7; const f32x4 v = *(const f32x4*)(a.router_w + (size_t)c * NE + ch * 4);
            *(LAS f32x4*)(lds + (c ^ ((c >> 5) & 1)) * 128 + ((ch ^ ((c >> 2) & 7)) * 16)) = v; }
        if (tid < 32) ldsx[128 + tid] = 0;
        __syncthreads();
        LAS int* pend = (LAS int*)(lds + LDSX_OFF + 1024);
        LAS float* lgs = (LAS float*)(lds + LDSX_OFF + 5120) + wave * 96;
        unsigned char* H8 = (unsigned char*)XN;
        int nloc = 0;
        const int NP = M / 2;
        f32x4 na[4], nb[4];
        if (gw < NP) {
#pragma unroll
            for (int j = 0; j < 4; ++j) { na[j] = *((const f32x4*)(x1 + (size_t)(2 * gw) * D) + lane + 64 * j); nb[j] = *((const f32x4*)(x1 + (size_t)(2 * gw + 1) * D) + lane + 64 * j); }
        }
        const int sw = lane & 7;
        const int myexp = ((lane >> 5) & 1) * 16 + ((lane >> 4) & 1) * 8 + ((lane >> 3) & 1) * 4 + ((lane >> 2) & 1) * 2 + ((lane >> 1) & 1);
        const float myrb = a.router_b[myexp];
        for (int p = gw; p < NP; p += NGW, nloc += 2) {
            float ha[16], hb[16]; float ssa = 0.f, ssb = 0.f;
#pragma unroll
            for (int j = 0; j < 4; ++j) { ha[4 * j] = na[j].x; ha[4 * j + 1] = na[j].y; ha[4 * j + 2] = na[j].z; ha[4 * j + 3] = na[j].w; hb[4 * j] = nb[j].x; hb[4 * j + 1] = nb[j].y; hb[4 * j + 2] = nb[j].z; hb[4 * j + 3] = nb[j].w;
                ssa += (na[j].x * na[j].x + na[j].y * na[j].y) + (na[j].z * na[j].z + na[j].w * na[j].w); ssb += (nb[j].x * nb[j].x + nb[j].y * nb[j].y) + (nb[j].z * nb[j].z + nb[j].w * nb[j].w); }
            if (p + NGW < NP) {
#pragma unroll
                for (int j = 0; j < 4; ++j) { na[j] = *((const f32x4*)(x1 + (size_t)(2 * (p + NGW)) * D) + lane + 64 * j); nb[j] = *((const f32x4*)(x1 + (size_t)(2 * (p + NGW) + 1) * D) + lane + 64 * j); }
            }
#pragma unroll
            for (int o = 1; o < 64; o <<= 1) { ssa += __shfl_xor(ssa, o); ssb += __shfl_xor(ssb, o); }
            const float ra = rsqrtf(ssa * (1.f / D) + RMS_EPS), rb = rsqrtf(ssb * (1.f / D) + RMS_EPS);
#pragma unroll
            for (int j = 0; j < 4; ++j) { const f32x4 gg = *((const f32x4*)a.norm2_g + lane + 64 * j);
                ha[4 * j + 0] *= ra * gg.x; ha[4 * j + 1] *= ra * gg.y; ha[4 * j + 2] *= ra * gg.z; ha[4 * j + 3] *= ra * gg.w;
                hb[4 * j + 0] *= rb * gg.x; hb[4 * j + 1] *= rb * gg.y; hb[4 * j + 2] *= rb * gg.z; hb[4 * j + 3] *= rb * gg.w;
                *((unsigned*)(H8 + (size_t)(2 * p) * D) + lane + 64 * j) = pk4_fp8(clamp448(ha[4 * j + 0] * H_SCALE), clamp448(ha[4 * j + 1] * H_SCALE), clamp448(ha[4 * j + 2] * H_SCALE), clamp448(ha[4 * j + 3] * H_SCALE));
                *((unsigned*)(H8 + (size_t)(2 * p + 1) * D) + lane + 64 * j) = pk4_fp8(clamp448(hb[4 * j + 0] * H_SCALE), clamp448(hb[4 * j + 1] * H_SCALE), clamp448(hb[4 * j + 2] * H_SCALE), clamp448(hb[4 * j + 3] * H_SCALE)); }
            f32x2 la[16], lb[16];
#pragma unroll
            for (int e = 0; e < 16; ++e) { la[e] = (f32x2){0.f, 0.f}; lb[e] = (f32x2){0.f, 0.f}; }
#pragma unroll
            for (int q = 0; q < 16; ++q) { const int c = 4 * lane + 256 * (q >> 2) + (q & 3); const LAS unsigned char* rp = lds + (c ^ ((lane >> 3) & 1)) * 128;
                f32x4 w[8];
#pragma unroll
                for (int ch = 0; ch < 8; ++ch) w[ch] = *(const LAS f32x4*)(rp + ((ch ^ sw) * 16));
                const f32x2 a2 = (f32x2){ha[q], ha[q]}, b2 = (f32x2){hb[q], hb[q]};
#pragma unroll
                for (int ch = 0; ch < 8; ++ch) { const f32x2 wl = (f32x2){w[ch].x, w[ch].y}, wh = (f32x2){w[ch].z, w[ch].w};
                    la[2 * ch] = __builtin_elementwise_fma(wl, a2, la[2 * ch]); la[2 * ch + 1] = __builtin_elementwise_fma(wh, a2, la[2 * ch + 1]);
                    lb[2 * ch] = __builtin_elementwise_fma(wl, b2, lb[2 * ch]); lb[2 * ch + 1] = __builtin_elementwise_fma(wh, b2, lb[2 * ch + 1]); } }
            float logit[2];
#pragma unroll
            for (int rw = 0; rw < 2; ++rw) {
                float v32[32];
#pragma unroll
                for (int e = 0; e < 16; ++e) { v32[2 * e] = rw ? lb[e].x : la[e].x; v32[2 * e + 1] = rw ? lb[e].y : la[e].y; }
                float v16[16];
#pragma unroll
                for (int e = 0; e < 16; ++e) { const float mine = (lane & 32) ? v32[e + 16] : v32[e], oth = (lane & 32) ? v32[e] : v32[e + 16]; v16[e] = mine + __shfl_xor(oth, 32); }
                float v8[8];
#pragma unroll
                for (int e = 0; e < 8; ++e) { const float mine = (lane & 16) ? v16[e + 8] : v16[e], oth = (lane & 16) ? v16[e] : v16[e + 8]; v8[e] = mine + __shfl_xor(oth, 16); }
                float v4[4];
#pragma unroll
                for (int e = 0; e < 4; ++e) { const float mine = (lane & 8) ? v8[e + 4] : v8[e], oth = (lane & 8) ? v8[e] : v8[e + 4]; v4[e] = mine + __shfl_xor(oth, 8); }
                float v2[2];
#pragma unroll
                for (int e = 0; e < 2; ++e) { const float mine = (lane & 4) ? v4[e + 2] : v4[e], oth = (lane & 4) ? v4[e] : v4[e + 2]; v2[e] = mine + __shfl_xor(oth, 4); }
                float v1; { const float mine = (lane & 2) ? v2[1] : v2[0], oth = (lane & 2) ? v2[0] : v2[1]; v1 = mine + __shfl_xor(oth, 2); }
                v1 += __shfl_xor(v1, 1);
                logit[rw] = v1 + myrb;
                lgs[rw * 32 + myexp] = logit[rw];
            }
            asm volatile("s_waitcnt lgkmcnt(0)" ::: "memory");
#pragma unroll
            for (int rw = 0; rw < 2; ++rw) {
                int rank = 0;
#pragma unroll
                for (int c4 = 0; c4 < 8; ++c4) { const f32x4 t = *(const LAS f32x4*)(lgs + rw * 32 + c4 * 4);
#pragma unroll
                    for (int i = 0; i < 4; ++i) { const int eo = c4 * 4 + i; rank += (t[i] > logit[rw] || (t[i] == logit[rw] && eo < myexp)) ? 1 : 0; } }
                if (rank < 4 && (lane & 1) == 0) { lgs[64 + rw * 8 + rank * 2] = __int_as_float(myexp); lgs[64 + rw * 8 + rank * 2 + 1] = logit[rw]; }
            }
            asm volatile("s_waitcnt lgkmcnt(0)" ::: "memory");
            if (lane < 8) { const int rw = lane >> 2, k = lane & 3;
                const f32x4 s0 = *(const LAS f32x4*)(lgs + 64 + rw * 8), s1 = *(const LAS f32x4*)(lgs + 64 + rw * 8 + 4);
                const float e1 = __expf(s0.w - s0.y), e2 = __expf(s1.y - s0.y), e3 = __expf(s1.w - s0.y); const float inv = 1.0f / (1.0f + e1 + e2 + e3);
                const int e = __float_as_int(k == 0 ? s0.x : k == 1 ? s0.z : k == 2 ? s1.x : s1.z); const float gt = (k == 0 ? 1.0f : k == 1 ? e1 : k == 2 ? e2 : e3) * inv;
                const int rank = __hip_atomic_fetch_add((LAS int*)(ldsx + 128 + e), 1, __ATOMIC_RELAXED, __HIP_MEMORY_SCOPE_WORKGROUP);
                LAS int* pe = pend + ((wave * 8 + nloc + rw) * 4 + k) * 4; pe[0] = e; pe[1] = rank; pe[2] = __float_as_int(gt); pe[3] = 2 * p + rw; }
            asm volatile("s_waitcnt lgkmcnt(0)" ::: "memory");
        }
        if (lane == 0) ldsx[224 + wave] = nloc;
        __syncthreads();
        if (tid < 32) ldsx[192 + tid] = (int)atomicAdd(cntp + tid, (unsigned)ldsx[128 + tid]);
        __syncthreads();
        if (tid < 256) { const int w8 = tid >> 5, rem = tid & 31, nl = rem >> 2, k = rem & 3;
            if (nl < ldsx[224 + w8]) { LAS int* pe = pend + ((w8 * 8 + nl) * 4 + k) * 4; const int e = pe[0], pos = ldsx[192 + e] + pe[1], m = pe[3];
                LTOKw[(size_t)e * M + pos] = m; LGATEw[(size_t)e * M + pos] = __int_as_float(pe[2]); TOKEw[m * 4 + k] = e; TOKPw[m * 4 + k] = pos; } }
      }
        if (IN(5)) GRID_BAR();
    }

    if (IN(5) || IN(6) || IN(7)) {
        __syncthreads();
        if (tid < 32) ldsx[64 + tid] = (int)__hip_atomic_load(ctl + CW_CNT + tid, __ATOMIC_RELAXED, __HIP_MEMORY_SCOPE_AGENT);
        __syncthreads();
        if (tid == 0) { int acc = 0; for (int e = 0; e < NE; ++e) { ldsx[e] = acc; acc += (ldsx[64 + e] + 255) >> 8; } ldsx[NE] = acc; }
        __syncthreads();
    }

    if (IN(5)) {
        pg8::MoeSched S{ldsx, ldsx + 64, 8, vcu / (G / 8), vcu % (G / 8), D, (const char*)WGU, (size_t)2048 * D, LTOK, true};
        pg8::EpiSwiglu E{(unsigned char*)ACT, a.b_gate, a.b_up};
        for (int rep = 0; rep < REP5; ++rep) pg8::gemm_phase<pg8::EpiSwiglu, pg8::MoeSched, true, true>(lds, (const char*)XN, D, S, E);
        if (IN(6)) GRID_BAR();
    }

    if (IN(6)) {
        pg8::MoeSched S{ldsx, ldsx + 64, 4, vcu / (G / 8), vcu % (G / 8), DFF, (const char*)WD, (size_t)D * DFF, LTOK, false};
        pg8::EpiDown E{Y, a.b_down, LGATE, ldsx};
        for (int rep = 0; rep < REP6; ++rep) pg8::gemm_phase<pg8::EpiDown, pg8::MoeSched, true, true>(lds, (const char*)ACT, DFF, S, E);
        if (IN(7)) GRID_BAR();
    }

    if (IN(7)) {
      for (int rep = 0; rep < REP7; ++rep) {
        float* outp = (rep + 1 < REP7) ? (float*)(ws + WS_ACT) : a.out;
        for (int m = gw; m < M; m += NGW) {
            const bf16_t* yr[4];
#pragma unroll
            for (int k = 0; k < 4; ++k) { const int e = TOKE[m * 4 + k], pos = TOKP[m * 4 + k]; yr[k] = Y + ((size_t)ldsx[e] * 256 + pos) * D; }
            f32x4 v[4]; float ss = 0.f;
#pragma unroll
            for (int j = 0; j < 4; ++j) { v[j] = *((const f32x4*)(x1 + (size_t)m * D) + lane + 64 * j);
#pragma unroll
                for (int k = 0; k < 4; ++k) { const u32x2 yv = *((const u32x2*)yr[k] + lane + 64 * j);
                    v[j].x += __uint_as_float(yv.x << 16); v[j].y += __uint_as_float(yv.x & 0xffff0000u); v[j].z += __uint_as_float(yv.y << 16); v[j].w += __uint_as_float(yv.y & 0xffff0000u); }
                ss += (v[j].x * v[j].x + v[j].y * v[j].y) + (v[j].z * v[j].z + v[j].w * v[j].w); }
            const float rstd = rsqrtf(wave_sum(ss) * (1.f / D) + RMS_EPS);
#pragma unroll
            for (int j = 0; j < 4; ++j) { const f32x4 gg = *((const f32x4*)a.final_g + lane + 64 * j); *((f32x4*)(outp + (size_t)m * D) + lane + 64 * j) = v[j] * rstd * gg; }
        }
      }
    }
#undef IN
#undef GRID_BAR
}

extern "C" void kernel_launch(void* const* d_in, const int* in_sizes, int n_in, void* d_out, int out_size, void* d_ws, size_t ws_size, hipStream_t stream) {
    static int grid = 0;
    if (grid == 0) {
        if (n_in != 22 || in_sizes[0] != M * D || out_size != M * D || ws_size < WS_END) { fprintf(stderr, "kernel_launch: unexpected shapes / workspace (n_in %d, ws %zu)\n", n_in, ws_size); grid = -1; return; }
        int dev = 0, cus = 0, per_cu = 0;
        (void)hipGetDevice(&dev); (void)hipDeviceGetAttribute(&cus, hipDeviceAttributeMultiprocessorCount, dev);
        (void)hipFuncSetAttribute((const void*)mk_fwd, hipFuncAttributeMaxDynamicSharedMemorySize, LDS_BYTES);
        (void)hipOccupancyMaxActiveBlocksPerMultiprocessor(&per_cu, (const void*)mk_fwd, 512, LDS_BYTES);
        (void)hipGetLastError();
        if (per_cu < 1) { fprintf(stderr, "kernel_launch: occupancy query says %d blocks per CU\n", per_cu); grid = -1; return; }
        grid = cus;
        if (grid % 8 != 0) grid -= grid % 8;
    }
    if (grid < 0) return;
    (void)hipMemsetAsync((char*)d_ws + WS_CTL, 0, CTL_ZERO_BYTES, stream);
    Args a{};
    const float** f = (const float**)&a;
    for (int i = 0; i < 22; ++i) f[i] = (const float*)d_in[i];
    a.out = (float*)d_out; a.ws = (unsigned char*)d_ws;
#if MK_N_LAUNCHES == 1
    a.ph_lo = 0; a.ph_hi = 8;
    void* args[] = {&a};
    hipError_t e = hipLaunchCooperativeKernel((const void*)mk_fwd, dim3(grid), dim3(512), args, LDS_BYTES, stream);
    if (e != hipSuccess) fprintf(stderr, "cooperative launch failed: %s (grid %d)\n", hipGetErrorString(e), grid);
#else
    for (int p = 0; p < 8; ++p) { a.ph_lo = p; a.ph_hi = p + 1; hipLaunchKernelGGL(mk_fwd, dim3(grid), dim3(512), LDS_BYTES, stream, a); }
#endif
}
```

```cpp
#include <hip/hip_runtime.h>
#include <hip/hip_cooperative_groups.h>
#include <cstdio>
#include <cstdint>
namespace cg = cooperative_groups;

#ifndef MK_N_LAUNCHES
#define MK_N_LAUNCHES 1
#endif

#ifndef REP0
#define REP0 1
#endif
#ifndef REP1
#define REP1 1
#endif
#ifndef REP2
#define REP2 1
#endif
#ifndef REP3
#define REP3 1
#endif
#ifndef REPPOOL
#define REPPOOL 1
#endif
#ifndef REP4
#define REP4 1
#endif
#ifndef REP7
#define REP7 1
#endif
#ifndef REP5
#define REP5 1
#endif
#ifndef REP6
#define REP6 1
#endif
#define LAS __attribute__((address_space(3)))
#define GAS __attribute__((address_space(1)))
typedef unsigned short bf16_t;
typedef short bf16x8 __attribute__((ext_vector_type(8)));
typedef short s16x4 __attribute__((ext_vector_type(4)));
typedef float f32x4 __attribute__((ext_vector_type(4)));
typedef float f32x2 __attribute__((ext_vector_type(2)));
typedef float f32x16 __attribute__((ext_vector_type(16)));
typedef unsigned u32x4 __attribute__((ext_vector_type(4)));
typedef unsigned u32x2 __attribute__((ext_vector_type(2)));
typedef __bf16 bf16x2_t __attribute__((ext_vector_type(2)));

constexpr int BATCH = 8, SEQ = 2048, D = 1024, M = BATCH * SEQ;
constexpr int NIN = 2048;
constexpr int NE = 32, TOPK = 4, DFF = 1024;
constexpr int NSLOT = M * TOPK;
constexpr int PADROWS = NSLOT + NE * 256;
constexpr float RMS_EPS = 1e-5f;
constexpr float QSCALE = 0.125f * 1.4426950408889634f;
constexpr float LAMBDA_INIT = 0.2f;

constexpr float W_SCALE = 64.0f, H_SCALE = 8.0f, ACT_SCALE = 4.0f;
constexpr float GU_DESCALE = 1.0f / (W_SCALE * H_SCALE), DN_DESCALE = 1.0f / (W_SCALE * ACT_SCALE);
constexpr size_t MiB = 1u << 20;
constexpr size_t WS_CTL = 0, CTL_ZERO_BYTES = 1 * MiB;
constexpr size_t WS_WIN = 1 * MiB;
constexpr size_t WS_WOUT = 5 * MiB;
constexpr size_t WS_WPOOL = 7 * MiB;
constexpr size_t WS_TOKE = 8 * MiB;
constexpr size_t WS_TOKP = WS_TOKE + 256 * 1024;
constexpr size_t WS_LTOK = 9 * MiB;
constexpr size_t WS_LGATE = 11 * MiB;
constexpr size_t WS_WD = 16 * MiB;
constexpr size_t WS_WGU = 80 * MiB;
constexpr size_t WS_ACT = 208 * MiB;
constexpr size_t WS_XN = 352 * MiB;
constexpr size_t WS_QKVU = 384 * MiB;
constexpr size_t WS_MIX = 448 * MiB;
constexpr size_t WS_Y = 352 * MiB;
constexpr size_t WS_END = 496 * MiB;
constexpr int CW_CNT = 64;
constexpr int CW_BAR = 4096;

constexpr int RING_BYTES = 131072;
constexpr int LDSX_OFF = RING_BYTES;
constexpr int LDS_BYTES = 147456;

__device__ __forceinline__ unsigned pk2(float lo, float hi) { f32x2 v = {lo, hi}; bf16x2_t b = __builtin_convertvector(v, bf16x2_t); return __builtin_bit_cast(unsigned, b); }
__device__ __forceinline__ unsigned pk4_fp8(float a, float b, float c, float d) { int w = 0; w = __builtin_amdgcn_cvt_pk_fp8_f32(a, b, w, false); w = __builtin_amdgcn_cvt_pk_fp8_f32(c, d, w, true); return (unsigned)w; }
__device__ __forceinline__ float clamp448(float v) { return fminf(fmaxf(v, -448.0f), 448.0f); }
__device__ __forceinline__ float bf2f(unsigned short h) { return __uint_as_float(((unsigned)h) << 16); }
__device__ __forceinline__ float wave_sum(float v) {
#pragma unroll
    for (int o = 1; o < 64; o <<= 1) v += __shfl_xor(v, o);
    return v;
}
__device__ __forceinline__ float wave_max(float v) {
#pragma unroll
    for (int o = 1; o < 64; o <<= 1) v = fmaxf(v, __shfl_xor(v, o));
    return v;
}
__device__ __forceinline__ int wave_min_i(int v) {
#pragma unroll
    for (int o = 1; o < 64; o <<= 1) { int w = __shfl_xor(v, o); v = w < v ? w : v; }
    return v;
}

namespace pg8 {
constexpr int BM = 256, BK = 64, HALF = 128, HTB = HALF * BK * 2, STAGE_BYTES = 8 * HTB;
__device__ __forceinline__ int lds_byte(int r, int c) { const int st = (r >> 4) * 2 + (c >> 5), rr = r & 15, cc = c & 31, ob = rr * 64 + cc * 2; return st * 1024 + (ob ^ (((ob >> 9) & 1) << 5)); }
__device__ __forceinline__ void stage_rc(int b, int& R, int& C) { const int st = b / 1024, sb = b % 1024, swz = sb ^ (((sb >> 9) & 1) << 5); R = (st >> 1) * 16 + swz / 64; C = (st & 1) * 32 + (swz % 64) / 2; }
__device__ __forceinline__ int perm32(int rho) { const int n = rho >> 4, i = rho & 15; return 8 * (i >> 2) + 4 * n + (i & 3); }

struct Unit { int pm, pn, e; unsigned a00, a01, a10, a11; const char* B; };

typedef int i32x4 __attribute__((ext_vector_type(4)));
typedef int i32x8 __attribute__((ext_vector_type(8)));
__device__ __forceinline__ i32x8 cat8(bf16x8 lo, bf16x8 hi) { return __builtin_shufflevector(__builtin_bit_cast(i32x4, lo), __builtin_bit_cast(i32x4, hi), 0, 1, 2, 3, 4, 5, 6, 7); }
template <class Epi, class Sched, bool ALIGN_EPI, bool FP8>
__device__ __forceinline__ void gemm_phase(LAS unsigned char* lds, const char* A, const int Kb, const Sched& S, const Epi& E) {
    const int tid = threadIdx.x, wid = __builtin_amdgcn_readfirstlane(tid >> 6), lane = tid & 63, wr = wid >> 2, wc = wid & 3, fr = lane & 15, fq = lane >> 4;
    int nt = Kb / 128; asm volatile("" : "+s"(nt));
    int R0, C0, R1, C1; stage_rc(tid * 16, R0, C0); stage_rc(tid * 16 + 8192, R1, C1);
    unsigned voffB[2];
    { const int Rb0 = Epi::PERM ? ((R0 & ~31) + perm32(R0 & 31)) : R0, Rb1 = Epi::PERM ? ((R1 & ~31) + perm32(R1 & 31)) : R1;
      voffB[0] = (unsigned)(Rb0 * Kb + C0 * 2); voffB[1] = (unsigned)(Rb1 * Kb + C1 * 2); }
    const size_t kstep = (size_t)(BK * 2);
    const size_t hstep = (size_t)HALF * Kb;
    const unsigned ldsw = (unsigned)wid * 1024u;
    const int aoff = lds_byte(wr * 64 + fr, fq * 8), boff = lds_byte(wc * 32 + fr, fq * 8);
#define PG8_SA(b, h) (((b) * 2 + (h)) * HTB)
#define PG8_SB(b, h) ((4 + (b) * 2 + (h)) * HTB)
#define PG8_STAGEB(bufoff, gbase) do { _Pragma("unroll") for (int _i = 0; _i < 2; ++_i) \
        __builtin_amdgcn_global_load_lds((const unsigned*)((const char*)(gbase) + voffB[_i]), (LAS unsigned*)(lds + (bufoff) + ldsw + _i * 8192), 16, 0, 0); } while (0)
#define PG8_STAGEA(bufoff, kb, o0, o1) do { \
        __builtin_amdgcn_global_load_lds((const unsigned*)(A + (size_t)(o0) + (kb)), (LAS unsigned*)(lds + (bufoff) + ldsw), 16, 0, 0); \
        __builtin_amdgcn_global_load_lds((const unsigned*)(A + (size_t)(o1) + (kb)), (LAS unsigned*)(lds + (bufoff) + ldsw + 8192), 16, 0, 0); } while (0)
#define PG8_LDA(dst, b, h) do { _Pragma("unroll") for (int m = 0; m < 4; ++m) { const i32x4 lo_ = *(const LAS i32x4*)(lds + PG8_SA(b, h) + aoff + m * 2048), hi_ = *(const LAS i32x4*)(lds + PG8_SA(b, h) + aoff + m * 2048 + 1024); \
        dst[m] = __builtin_shufflevector(lo_, hi_, 0, 1, 2, 3, 4, 5, 6, 7); } } while (0)
#define PG8_LDB(dst, b, h) do { _Pragma("unroll") for (int n = 0; n < 2; ++n) { const i32x4 lo_ = *(const LAS i32x4*)(lds + PG8_SB(b, h) + boff + n * 2048), hi_ = *(const LAS i32x4*)(lds + PG8_SB(b, h) + boff + n * 2048 + 1024); \
        dst[n] = __builtin_shufflevector(lo_, hi_, 0, 1, 2, 3, 4, 5, 6, 7); } } while (0)
#define PG8_LO(v) __builtin_bit_cast(bf16x8, __builtin_shufflevector(v, v, 0, 1, 2, 3))
#define PG8_HI(v) __builtin_bit_cast(bf16x8, __builtin_shufflevector(v, v, 4, 5, 6, 7))
#define PG8_MMA(ai, bj, At, Bt) do { __builtin_amdgcn_s_setprio(1); if constexpr (FP8) { _Pragma("unroll") for (int m = 0; m < 4; ++m) _Pragma("unroll") for (int n = 0; n < 2; ++n) \
        asm volatile("s_nop 1\n\tv_mfma_f32_16x16x128_f8f6f4 %0, %1, %2, %0" : "+v"(acc[ai][bj][m][n]) : "v"(Bt[n]), "v"(At[m])); } else { \
        _Pragma("unroll") for (int m = 0; m < 4; ++m) _Pragma("unroll") for (int n = 0; n < 2; ++n) { \
        acc[ai][bj][m][n] = __builtin_amdgcn_mfma_f32_16x16x32_bf16(PG8_LO(Bt[n]), PG8_LO(At[m]), acc[ai][bj][m][n], 0, 0, 0); \
        acc[ai][bj][m][n] = __builtin_amdgcn_mfma_f32_16x16x32_bf16(PG8_HI(Bt[n]), PG8_HI(At[m]), acc[ai][bj][m][n], 0, 0, 0); } } __builtin_amdgcn_s_setprio(0); } while (0)
#define PG8_WAIT_V(n) asm volatile("s_waitcnt vmcnt(" #n ")" ::: "memory")
#define PG8_WAIT_L(n) asm volatile("s_waitcnt lgkmcnt(" #n ")" ::: "memory")
#define PG8_BAR __builtin_amdgcn_s_barrier()
#define PG8_SCHED __builtin_amdgcn_sched_barrier(0)
    Unit cur, nxt; int ui = 0;
    if (!S.next(0, cur, R0, C0, R1, C1)) return;
    f32x4 acc[2][2][4][2];
#pragma unroll
    for (int a = 0; a < 2; ++a)
#pragma unroll
        for (int b = 0; b < 2; ++b)
#pragma unroll
            for (int m = 0; m < 4; ++m)
#pragma unroll
                for (int n = 0; n < 2; ++n) acc[a][b][m][n] = (f32x4){0.f, 0.f, 0.f, 0.f};
    i32x8 At[4], B0[2], B1[2];
    const char* cB = cur.B;
    PG8_STAGEB(PG8_SB(0, 0), cB); PG8_STAGEB(PG8_SB(0, 1), cB + hstep); PG8_STAGEA(PG8_SA(0, 0), 0, cur.a00, cur.a01); PG8_STAGEA(PG8_SA(0, 1), 0, cur.a10, cur.a11);
    if (wr == 1) PG8_BAR;
    PG8_WAIT_V(2); PG8_BAR;
    PG8_STAGEB(PG8_SB(1, 0), cB + kstep); PG8_STAGEA(PG8_SA(1, 0), kstep, cur.a00, cur.a01); PG8_STAGEB(PG8_SB(1, 1), cB + hstep + kstep);
    PG8_WAIT_V(6); PG8_BAR;
    for (;;) {
        const bool has_next = S.next(ui + 1, nxt, R0, C0, R1, C1);
        if (!has_next) nxt = cur;
        const char* nB = nxt.B;
#pragma unroll 1
        for (int t = 0; t < nt; t += 2) {
            const bool last = (t == nt - 2);
            const size_t k1 = (size_t)(t + 1) * kstep;
            const size_t k2 = last ? 0 : (size_t)(t + 2) * kstep, k3 = k2 + kstep;
            const char* b2 = last ? nB : cB + (size_t)(t + 2) * kstep; const char* b3 = b2 + kstep;
            const unsigned s00 = last ? nxt.a00 : cur.a00, s01 = last ? nxt.a01 : cur.a01, s10 = last ? nxt.a10 : cur.a10, s11 = last ? nxt.a11 : cur.a11;
            PG8_LDB(B0, 0, 0); PG8_LDB(B1, 0, 1); PG8_SCHED; PG8_LDA(At, 0, 0); PG8_STAGEA(PG8_SA(1, 1), k1, cur.a10, cur.a11);
            PG8_WAIT_V(8); PG8_WAIT_L(0); PG8_BAR; PG8_MMA(0, 0, At, B0); PG8_MMA(0, 1, At, B1); PG8_BAR; PG8_SCHED;
            PG8_LDA(At, 0, 1); PG8_STAGEB(PG8_SB(0, 0), b2); PG8_STAGEB(PG8_SB(0, 1), b2 + hstep); PG8_STAGEA(PG8_SA(0, 0), k2, s00, s01);
            PG8_WAIT_V(8); PG8_WAIT_L(0); PG8_BAR; PG8_MMA(1, 0, At, B0); PG8_MMA(1, 1, At, B1); PG8_BAR; PG8_SCHED;
            PG8_LDB(B0, 1, 0); PG8_LDB(B1, 1, 1); PG8_SCHED; PG8_LDA(At, 1, 0); PG8_STAGEA(PG8_SA(0, 1), k2, s10, s11);
            PG8_WAIT_V(8); PG8_WAIT_L(0); PG8_BAR; PG8_MMA(0, 0, At, B0); PG8_MMA(0, 1, At, B1); PG8_BAR; PG8_SCHED;
            PG8_LDA(At, 1, 1); PG8_STAGEB(PG8_SB(1, 0), b3); PG8_STAGEB(PG8_SB(1, 1), b3 + hstep); PG8_STAGEA(PG8_SA(1, 0), k3, s00, s01);
            PG8_WAIT_V(8); PG8_WAIT_L(0); PG8_BAR; PG8_MMA(1, 0, At, B0); PG8_MMA(1, 1, At, B1); PG8_BAR; PG8_SCHED;
        }
        if constexpr (ALIGN_EPI) { if (wr == 0) PG8_BAR; }
        if constexpr (FP8) { PG8_SCHED; asm volatile("s_nop 15\n\ts_nop 7" ::: "memory"); PG8_SCHED; }
        E(acc, cur, wr, wc, fr, fq);
        if (!has_next) break;
#pragma unroll
        for (int a = 0; a < 2; ++a)
#pragma unroll
            for (int b = 0; b < 2; ++b)
#pragma unroll
                for (int m = 0; m < 4; ++m)
#pragma unroll
                    for (int n = 0; n < 2; ++n) acc[a][b][m][n] = (f32x4){0.f, 0.f, 0.f, 0.f};
        cur = nxt; cB = nB; ++ui;
        if constexpr (ALIGN_EPI) { if (wr == 1) PG8_BAR; }
    }
    PG8_WAIT_V(0);
    if constexpr (!ALIGN_EPI) { if (wr == 0) PG8_BAR; }
    PG8_BAR;
#undef PG8_SA
#undef PG8_SB
#undef PG8_STAGEA
#undef PG8_STAGEB
#undef PG8_LDA
#undef PG8_LDB
#undef PG8_LO
#undef PG8_HI
#undef PG8_MMA
#undef PG8_WAIT_V
#undef PG8_WAIT_L
#undef PG8_BAR
#undef PG8_SCHED
}

struct DenseSched {
    int nM, nN, nwg, G, c, Kb, dup; const char* Bt;
    __device__ __forceinline__ void init(int Mr, int N, int Kb_, int G_, int c_, const void* Bt_, int dup_) { nM = Mr / BM; nN = N / BM; nwg = nM * nN; G = G_; c = c_; Kb = Kb_; Bt = (const char*)Bt_; dup = dup_; }
    __device__ __forceinline__ bool next(int i, Unit& u, int R0, int C0, int R1, int C1) const {
        const long L = (long)(i / dup) * G + c; if (L >= nwg) return false;
        int wgid = (int)L; { const int q = nwg / 8, r = nwg % 8, xcd = wgid % 8, off = wgid / 8; wgid = (xcd < r ? xcd * (q + 1) : r * (q + 1) + (xcd - r) * q) + off; }
        const int WGM = 8, nig = WGM * nN, gid = wgid / nig, fm = gid * WGM, gsz = (nM - fm) < WGM ? (nM - fm) : WGM;
        u.pm = fm + ((wgid % nig) % gsz); u.pn = (wgid % nig) / gsz; u.e = 0;
        const unsigned rb = (unsigned)u.pm * 256u;
        u.a00 = (rb + R0) * Kb + C0 * 2; u.a01 = (rb + R1) * Kb + C1 * 2; u.a10 = (rb + 128 + R0) * Kb + C0 * 2; u.a11 = (rb + 128 + R1) * Kb + C1 * 2;
        u.B = Bt + (size_t)u.pn * 256 * Kb; return true;
    }
};
struct MoeSched {
    const LAS int* tp; const LAS int* cnt; int NT; int xcd, j; int Kb; const char* W; size_t wstride; const int* ltok; bool gather;
    __device__ __forceinline__ int rd(const LAS int* p) const { return __builtin_amdgcn_readfirstlane(*p); }
    __device__ __forceinline__ bool next(int i, Unit& u, int R0, int C0, int R1, int C1) const {
        const int U = rd(tp + NE) * NT; const int lo = (int)(((long)xcd * U) / 8), hi = (int)(((long)(xcd + 1) * U) / 8);
        const int L = lo + i * 32 + j; if (L >= hi) return false;
        int e = 0;
        for (int q = 1; q < NE; ++q) e = (L >= rd(tp + q) * NT) ? q : e;
        const int tpe = rd(tp + e), nte = rd(tp + e + 1) - tpe, r = L - tpe * NT, pn = r / nte, mt = r % nte;
        u.e = e; u.pn = pn; u.pm = tpe + mt;
        if (gather) {
            const int ce = rd(cnt + e); const int* lt = ltok + (size_t)e * M;
            const int i00 = mt * 256 + R0, i01 = mt * 256 + R1, i10 = i00 + 128, i11 = i01 + 128;
            const unsigned t00 = i00 < ce ? (unsigned)lt[i00] : 0u, t01 = i01 < ce ? (unsigned)lt[i01] : 0u, t10 = i10 < ce ? (unsigned)lt[i10] : 0u, t11 = i11 < ce ? (unsigned)lt[i11] : 0u;
            u.a00 = t00 * Kb + C0 * 2; u.a01 = t01 * Kb + C1 * 2; u.a10 = t10 * Kb + C0 * 2; u.a11 = t11 * Kb + C1 * 2;
        } else {
            const unsigned rb = (unsigned)u.pm * 256u;
            u.a00 = (rb + R0) * Kb + C0 * 2; u.a01 = (rb + R1) * Kb + C1 * 2; u.a10 = (rb + 128 + R0) * Kb + C0 * 2; u.a11 = (rb + 128 + R1) * Kb + C1 * 2;
        }
        u.B = W + (size_t)e * wstride + (size_t)pn * 256 * Kb; return true;
    }
};

struct EpiQkvu {
    static constexpr bool PERM = true; bf16_t* O;
    __device__ __forceinline__ void operator()(const f32x4 (&acc)[2][2][4][2], const Unit& u, int wr, int wc, int fr, int fq) const {
        const int row0 = u.pm * BM + wr * 64 + fr, col0 = u.pn * BM + wc * 32 + 8 * fq; const float sc = (u.pn < 2) ? QSCALE : 1.f;
#pragma unroll
        for (int ai = 0; ai < 2; ++ai)
#pragma unroll
            for (int m = 0; m < 4; ++m) { bf16_t* rowp = O + (size_t)(row0 + ai * HALF + m * 16) * NIN + col0;
#pragma unroll
                for (int bj = 0; bj < 2; ++bj) { const f32x4 v0 = acc[ai][bj][m][0] * sc, v1 = acc[ai][bj][m][1] * sc;
                    u32x4 w; w.x = pk2(v0[0], v0[1]); w.y = pk2(v0[2], v0[3]); w.z = pk2(v1[0], v1[1]); w.w = pk2(v1[2], v1[3]);
                    *(u32x4*)(rowp + bj * HALF) = w; } }
    }
};
struct EpiResF32 {
    static constexpr bool PERM = false; const float* base; float* out;
    __device__ __forceinline__ void operator()(const f32x4 (&acc)[2][2][4][2], const Unit& u, int wr, int wc, int fr, int fq) const {
        const int col0 = u.pn * BM + wc * 32 + 4 * fq;
#pragma unroll
        for (int ai = 0; ai < 2; ++ai)
#pragma unroll
            for (int m = 0; m < 4; ++m) { const size_t off = (size_t)(u.pm * BM + ai * HALF + wr * 64 + m * 16 + fr) * D + col0;
#pragma unroll
                for (int bj = 0; bj < 2; ++bj)
#pragma unroll
                    for (int n = 0; n < 2; ++n) { const f32x4 bs = *(const f32x4*)(base + off + bj * HALF + n * 16); *(f32x4*)(out + off + bj * HALF + n * 16) = bs + acc[ai][bj][m][n]; } }
    }
};
struct EpiSwiglu {
    static constexpr bool PERM = true; unsigned char* ACT; const float* bg; const float* bu;
    __device__ __forceinline__ void operator()(const f32x4 (&acc)[2][2][4][2], const Unit& u, int wr, int wc, int fr, int fq) const {
        const int row0 = u.pm * BM + wr * 64 + fr, col0 = u.pn * 128 + wc * 32 + 8 * fq;
        f32x4 g4[2], u4[2];
#pragma unroll
        for (int n = 0; n < 2; ++n) { g4[n] = *(const f32x4*)(bg + (size_t)u.e * DFF + col0 + 4 * n); u4[n] = *(const f32x4*)(bu + (size_t)u.e * DFF + col0 + 4 * n); }
#pragma unroll
        for (int ai = 0; ai < 2; ++ai)
#pragma unroll
            for (int m = 0; m < 4; ++m) { float a[8];
#pragma unroll
                for (int n = 0; n < 2; ++n)
#pragma unroll
                    for (int j = 0; j < 4; ++j) { const float g = fminf(acc[ai][0][m][n][j] * GU_DESCALE + g4[n][j], 7.0f); const float up = fminf(fmaxf(acc[ai][1][m][n][j] * GU_DESCALE + u4[n][j], -7.0f), 7.0f);
                        const float sg = __builtin_amdgcn_rcpf(1.0f + __builtin_amdgcn_exp2f(-1.702f * 1.4426950408889634f * g)); a[n * 4 + j] = g * sg * (up + 1.0f) * ACT_SCALE; }
                u32x2 w; w.x = pk4_fp8(a[0], a[1], a[2], a[3]); w.y = pk4_fp8(a[4], a[5], a[6], a[7]);
                *(u32x2*)(ACT + (size_t)(row0 + ai * HALF + m * 16) * DFF + col0) = w; }
    }
};
struct EpiDown {
    static constexpr bool PERM = true; bf16_t* Y; const float* bd; const float* lgate; const LAS int* tp;
    __device__ __forceinline__ void operator()(const f32x4 (&acc)[2][2][4][2], const Unit& u, int wr, int wc, int fr, int fq) const {
        const int mt = u.pm - tp[u.e]; const int row0 = u.pm * BM + wr * 64 + fr, col0 = u.pn * BM + wc * 32 + 8 * fq;
        const float* lg = lgate + (size_t)u.e * M + mt * 256 + wr * 64 + fr;
        f32x4 bv[2][2];
#pragma unroll
        for (int bj = 0; bj < 2; ++bj)
#pragma unroll
            for (int n = 0; n < 2; ++n) bv[bj][n] = *(const f32x4*)(bd + (size_t)u.e * D + col0 + bj * HALF + 4 * n);
#pragma unroll
        for (int ai = 0; ai < 2; ++ai)
#pragma unroll
            for (int m = 0; m < 4; ++m) { const float gt = lg[ai * HALF + m * 16]; bf16_t* rowp = Y + (size_t)(row0 + ai * HALF + m * 16) * D + col0;
#pragma unroll
                for (int bj = 0; bj < 2; ++bj) { const f32x4 v0 = (acc[ai][bj][m][0] * DN_DESCALE + bv[bj][0]) * gt, v1 = (acc[ai][bj][m][1] * DN_DESCALE + bv[bj][1]) * gt;
                    u32x4 w; w.x = pk2(v0[0], v0[1]); w.y = pk2(v0[2], v0[3]); w.z = pk2(v1[0], v1[1]); w.w = pk2(v1[2], v1[3]);
                    *(u32x4*)(rowp + bj * HALF) = w; } }
    }
};
}

namespace att {
__device__ __forceinline__ int crow(int r, int hi) { return (r & 3) + 8 * (r >> 2) + 4 * hi; }
__device__ __forceinline__ s16x4 vtr(const LAS unsigned char* p) { typedef short v4 __attribute__((ext_vector_type(4))); return __builtin_bit_cast(s16x4, __builtin_amdgcn_ds_read_tr16_b64_v4i16((LAS v4*)p)); }

__device__ __forceinline__ void attn_unit(int b, int h, int qb, const bf16_t* QKVU, bf16_t* MIX, LAS unsigned char* lds, float lam, const float* subln_g) {
    const int tid = threadIdx.x, lane = tid & 63, r32 = lane & 31, hi = lane >> 5; const int wid = __builtin_amdgcn_readfirstlane(tid >> 6);
    const int map = wid >> 2, wq = wid & 3;
    const long rowbase = (long)b * SEQ; const int q0 = qb * 128;
    const int NT = 2 * qb + 2;
    const bf16_t* Qp = QKVU + (size_t)(rowbase + q0 + wq * 32 + r32) * NIN + h * 128 + map * 64 + hi * 8;
    bf16x8 qr[4];
#pragma unroll
    for (int d0 = 0; d0 < 4; ++d0) qr[d0] = *(const bf16x8*)(Qp + d0 * 16);
    const bf16_t* ksrc[2]; const bf16_t* vsrc[2];
#pragma unroll
    for (int i = 0; i < 2; ++i) { const int p = 2 * wid + i;
        ksrc[i] = QKVU + (size_t)(rowbase + lane) * NIN + 512 + h * 128 + (p >> 3) * 64 + (p & 7) * 8;
        vsrc[i] = QKVU + (size_t)(rowbase + 16 * (p & 3) + (lane >> 2)) * NIN + 1024 + h * 128 + (p >> 2) * 32 + (lane & 3) * 8; }
#define ATT_DMA(t, buf) do { _Pragma("unroll") for (int _i = 0; _i < 2; ++_i) { \
        __builtin_amdgcn_global_load_lds((const unsigned*)(ksrc[_i] + (size_t)(t) * 64 * NIN), (LAS unsigned*)(lds + (buf) * 32768 + (2 * wid + _i) * 1024), 16, 0, 0); \
        __builtin_amdgcn_global_load_lds((const unsigned*)(vsrc[_i] + (size_t)(t) * 64 * NIN), (LAS unsigned*)(lds + (buf) * 32768 + 16384 + (2 * wid + _i) * 1024), 16, 0, 0); } } while (0)
    float m_run = -INFINITY, l_run = 0.f;
    f32x16 o[4];
#pragma unroll
    for (int d0 = 0; d0 < 4; ++d0) o[d0] = f32x16{};
    const int qabs = q0 + wq * 32 + r32;
    ATT_DMA(0, 0);
    for (int t = 0; t < NT; ++t) {
        __syncthreads();
        if (t + 1 < NT) ATT_DMA(t + 1, (t + 1) & 1);
        if (64 * t <= q0 + wq * 32 + 31) {
            const LAS unsigned char* Kb = lds + (t & 1) * 32768 + map * 8192 + hi * 1024 + r32 * 16;
            const LAS unsigned char* Vb = lds + (t & 1) * 32768 + 16384 + ((lane >> 4) & 1) * 32 + (lane & 3) * 8 + (4 * hi + ((lane & 15) >> 2)) * 64;
            f32x16 p0 = f32x16{}, p1 = f32x16{};
#pragma unroll
            for (int d0 = 0; d0 < 4; ++d0) {
                const bf16x8 k0 = *(const LAS bf16x8*)(Kb + d0 * 2048), k1 = *(const LAS bf16x8*)(Kb + d0 * 2048 + 512);
                p0 = __builtin_amdgcn_mfma_f32_32x32x16_bf16(k0, qr[d0], p0, 0, 0, 0);
                p1 = __builtin_amdgcn_mfma_f32_32x32x16_bf16(k1, qr[d0], p1, 0, 0, 0);
            }
            if (t >= NT - 2) {
#pragma unroll
                for (int r = 0; r < 16; ++r) { const int kv = 64 * t + crow(r, hi); if (kv > qabs) p0[r] = -INFINITY; if (kv + 32 > qabs) p1[r] = -INFINITY; }
            }
            float rm = fmaxf(p0[0], p1[0]);
#pragma unroll
            for (int r = 1; r < 16; ++r) rm = fmaxf(rm, fmaxf(p0[r], p1[r]));
            { auto rr = __builtin_amdgcn_permlane32_swap(__float_as_uint(rm), __float_as_uint(rm), false, false); rm = fmaxf(__uint_as_float(rr[0]), __uint_as_float(rr[1])); }
            const float mnew = fmaxf(m_run, rm);
            const float f = __builtin_amdgcn_exp2f(m_run - mnew);
            m_run = mnew;
            float ls = 0.f;
#pragma unroll
            for (int r = 0; r < 16; ++r) { p0[r] = __builtin_amdgcn_exp2f(p0[r] - mnew); p1[r] = __builtin_amdgcn_exp2f(p1[r] - mnew); ls += p0[r] + p1[r]; }
            l_run = l_run * f + ls;
            if (!__all(f == 1.0f)) {
#pragma unroll
                for (int d0 = 0; d0 < 4; ++d0)
#pragma unroll
                    for (int r = 0; r < 16; ++r) o[d0][r] *= f;
            }
            bf16x8 pa[4];
#pragma unroll
            for (int s = 0; s < 2; ++s) {
                u32x4 w0, w1;
                w0.x = pk2(p0[8 * s + 0], p0[8 * s + 1]); w0.y = pk2(p0[8 * s + 2], p0[8 * s + 3]); w0.z = pk2(p0[8 * s + 4], p0[8 * s + 5]); w0.w = pk2(p0[8 * s + 6], p0[8 * s + 7]);
                w1.x = pk2(p1[8 * s + 0], p1[8 * s + 1]); w1.y = pk2(p1[8 * s + 2], p1[8 * s + 3]); w1.z = pk2(p1[8 * s + 4], p1[8 * s + 5]); w1.w = pk2(p1[8 * s + 6], p1[8 * s + 7]);
                pa[s] = __builtin_bit_cast(bf16x8, w0); pa[2 + s] = __builtin_bit_cast(bf16x8, w1);
            }
#pragma unroll
            for (int d0 = 0; d0 < 4; ++d0) {
#pragma unroll
                for (int ks = 0; ks < 4; ++ks) {
                    const s16x4 lo = vtr(Vb + (d0 * 4 + ks) * 1024), hh = vtr(Vb + (d0 * 4 + ks) * 1024 + 512);
                    const bf16x8 vf = (bf16x8){lo[0], lo[1], lo[2], lo[3], hh[0], hh[1], hh[2], hh[3]};
                    o[d0] = __builtin_amdgcn_mfma_f32_32x32x16_bf16(vf, pa[ks], o[d0], 0, 0, 0);
                }
            }
        }
    }
#undef ATT_DMA
    { auto rr = __builtin_amdgcn_permlane32_swap(__float_as_uint(l_run), __float_as_uint(l_run), false, false); l_run = __uint_as_float(rr[0]) + __uint_as_float(rr[1]); }
    const float rl = 1.0f / l_run;
    __syncthreads();
    LAS float* xs = (LAS float*)lds + wq * 4096 + lane;
    if (map == 1) {
#pragma unroll
        for (int d0 = 0; d0 < 4; ++d0)
#pragma unroll
            for (int r = 0; r < 16; ++r) xs[(d0 * 16 + r) * 64] = o[d0][r] * rl;
    }
    __syncthreads();
    if (map == 0) {
        float ss = 0.f;
#pragma unroll
        for (int d0 = 0; d0 < 4; ++d0)
#pragma unroll
            for (int r = 0; r < 16; ++r) { const float a = o[d0][r] * rl - lam * xs[(d0 * 16 + r) * 64]; o[d0][r] = a; ss += a * a; }
        { auto rr = __builtin_amdgcn_permlane32_swap(__float_as_uint(ss), __float_as_uint(ss), false, false); ss = __uint_as_float(rr[0]) + __uint_as_float(rr[1]); }
        const float rs = rsqrtf(ss * (1.0f / 128.0f) + RMS_EPS) * (1.0f - LAMBDA_INIT);
        bf16_t* Op = MIX + (size_t)(rowbase + qabs) * D + h * 128 + 4 * hi;
#pragma unroll
        for (int d0 = 0; d0 < 4; ++d0)
#pragma unroll
            for (int g = 0; g < 4; ++g) { const int dv = d0 * 32 + 8 * g + 4 * hi; const f32x4 sg = *(const f32x4*)(subln_g + dv);
                u32x2 w; w.x = pk2(o[d0][4 * g + 0] * rs * sg[0], o[d0][4 * g + 1] * rs * sg[1]); w.y = pk2(o[d0][4 * g + 2] * rs * sg[2], o[d0][4 * g + 3] * rs * sg[3]);
                *(u32x2*)(Op + d0 * 32 + 8 * g) = w; }
    }
    __syncthreads();
}
}

__device__ __forceinline__ void pool_strip(int strip, const bf16_t* QKVU, const float* b_pool, const float* pool_scale, bf16_t* MIX, int lane) {
    const int t0 = strip * 8, s0 = t0 % SEQ, g = lane >> 4, w = 2 << g;
    u32x4 raw[23];
#pragma unroll
    for (int i = 0; i < 23; ++i) { raw[i] = (u32x4){0u, 0u, 0u, 0u}; if (s0 + i - 15 >= 0) raw[i] = *(const u32x4*)(QKVU + (size_t)(t0 + i - 15) * NIN + 1536 + lane * 8); }
    float mk[16];
#pragma unroll
    for (int j = 0; j < 16; ++j) mk[j] = (j < w) ? 1.0f : 0.0f;
    const f32x4 b0 = *(const f32x4*)(b_pool + lane * 8), b1 = *(const f32x4*)(b_pool + lane * 8 + 4), sc0 = *(const f32x4*)(pool_scale + lane * 8), sc1 = *(const f32x4*)(pool_scale + lane * 8 + 4);
    u32x4 outp[8];
#pragma unroll
    for (int hf = 0; hf < 2; ++hf) {
        float v[23][4];
#pragma unroll
        for (int i = 0; i < 23; ++i) { const unsigned lo = hf ? raw[i].z : raw[i].x, hi = hf ? raw[i].w : raw[i].y;
            v[i][0] = __uint_as_float(lo << 16); v[i][1] = __uint_as_float(lo & 0xffff0000u); v[i][2] = __uint_as_float(hi << 16); v[i][3] = __uint_as_float(hi & 0xffff0000u); }
        const f32x4 bb = hf ? b1 : b0, ss = hf ? sc1 : sc0;
#pragma unroll
        for (int r = 0; r < 8; ++r) { float acc[4] = {0.f, 0.f, 0.f, 0.f};
#pragma unroll
            for (int j = 0; j < 16; ++j)
#pragma unroll
                for (int c = 0; c < 4; ++c) acc[c] += mk[j] * v[15 + r - j][c];
            const int pos1 = s0 + r + 1; const float inv = 1.0f / (float)(pos1 < w ? pos1 : w);
            float o[4];
#pragma unroll
            for (int c = 0; c < 4; ++c) o[c] = (acc[c] * inv - v[15 + r][c] + bb[c]) * ss[c];
            if (hf == 0) { outp[r].x = pk2(o[0], o[1]); outp[r].y = pk2(o[2], o[3]); } else { outp[r].z = pk2(o[0], o[1]); outp[r].w = pk2(o[2], o[3]); } }
    }
#pragma unroll
    for (int r = 0; r < 8; ++r) *(u32x4*)(MIX + (size_t)(t0 + r) * D + 512 + lane * 8) = outp[r];
}
__device__ __forceinline__ void fold_pool_item(const float* w_in, const float* w_pool, bf16_t* WINT, int g, int k0, int d0, int lane) {
    const int lr = lane & 15, lq = lane >> 4;
    f32x4 acc[4];
#pragma unroll
    for (int db = 0; db < 4; ++db) acc[db] = (f32x4){0.f, 0.f, 0.f, 0.f};
    const float* xr = w_in + (size_t)(k0 + lr) * NIN + 1536 + 128 * g + 4 * lq; const float* wpb = w_pool + (size_t)g * 16384 + d0 + lr;
#pragma unroll 2
    for (int c16 = 0; c16 < 8; ++c16) { const f32x4 x = *(const f32x4*)(xr + 16 * c16);
#pragma unroll
        for (int t = 0; t < 4; ++t)
#pragma unroll
            for (int db = 0; db < 4; ++db) { const float aw = wpb[(size_t)(16 * c16 + 4 * lq + t) * 128 + 16 * db]; acc[db] = __builtin_amdgcn_mfma_f32_16x16x4f32(aw, x[t], acc[db], 0, 0, 0); } }
#pragma unroll
    for (int db = 0; db < 4; ++db)
#pragma unroll
        for (int r = 0; r < 4; ++r) WINT[(size_t)(1536 + 128 * g + d0 + 16 * db + 4 * lq + r) * D + k0 + lr] = (bf16_t)(pk2(acc[db][r], 0.f) & 0xffffu);
}

__device__ __forceinline__ void transpose_item(const float* W, int N, int k0, int n0, bf16_t* WT, int K, int drow0, LAS float* scr, int lane) {
#pragma unroll 8
    for (int i = 0; i < 32; ++i) { const int kk = 2 * i + (lane >> 5); scr[kk * 33 + (lane & 31)] = W[(size_t)(k0 + kk) * N + n0 + (lane & 31)]; }
    asm volatile("s_waitcnt lgkmcnt(0)" ::: "memory");
    const int c = lane & 7;
#pragma unroll
    for (int j = 0; j < 4; ++j) { const int n = (lane >> 3) + 8 * j; const LAS float* s = scr + (8 * c) * 33 + n;
        u32x4 o; o.x = pk2(s[0 * 33], s[1 * 33]); o.y = pk2(s[2 * 33], s[3 * 33]); o.z = pk2(s[4 * 33], s[5 * 33]); o.w = pk2(s[6 * 33], s[7 * 33]);
        *(u32x4*)(WT + (size_t)(drow0 + n) * K + k0 + 8 * c) = o; }
    asm volatile("s_waitcnt lgkmcnt(0)" ::: "memory");
}
__device__ __forceinline__ void transpose_item_fp8(const float* W, int N, int k0, int n0, unsigned char* WT, int K, int drow0, LAS float* scr, int lane) {
#pragma unroll 8
    for (int i = 0; i < 32; ++i) { const int kk = 2 * i + (lane >> 5); scr[kk * 33 + (lane & 31)] = W[(size_t)(k0 + kk) * N + n0 + (lane & 31)]; }
    asm volatile("s_waitcnt lgkmcnt(0)" ::: "memory");
    const int c = lane & 3;
#pragma unroll
    for (int j = 0; j < 2; ++j) { const int n = (lane >> 2) + 16 * j; const LAS float* s = scr + (16 * c) * 33 + n;
        float v[16];
#pragma unroll
        for (int i = 0; i < 16; ++i) v[i] = clamp448(s[i * 33] * W_SCALE);
        u32x4 o; o.x = pk4_fp8(v[0], v[1], v[2], v[3]); o.y = pk4_fp8(v[4], v[5], v[6], v[7]); o.z = pk4_fp8(v[8], v[9], v[10], v[11]); o.w = pk4_fp8(v[12], v[13], v[14], v[15]);
        *(u32x4*)(WT + (size_t)(drow0 + n) * K + k0 + 16 * c) = o; }
    asm volatile("s_waitcnt lgkmcnt(0)" ::: "memory");
}
__device__ __forceinline__ void rms_row_to_bf16(const float* xrow, const float* g, bf16_t* orow, int lane) {
    const f32x4* xr = (const f32x4*)xrow + lane; const f32x4* gr = (const f32x4*)g + lane;
    f32x4 v[4]; float s = 0.f;
#pragma unroll
    for (int j = 0; j < 4; ++j) { v[j] = xr[64 * j]; s += (v[j].x * v[j].x + v[j].y * v[j].y) + (v[j].z * v[j].z + v[j].w * v[j].w); }
    const float rstd = rsqrtf(wave_sum(s) * (1.f / D) + RMS_EPS);
    u32x2* o8 = (u32x2*)orow + lane;
#pragma unroll
    for (int j = 0; j < 4; ++j) { const f32x4 gg = gr[64 * j]; u32x2 w; w.x = pk2(v[j].x * rstd * gg.x, v[j].y * rstd * gg.y); w.y = pk2(v[j].z * rstd * gg.z, v[j].w * rstd * gg.w); o8[64 * j] = w; }
}


#define XB_TMO      128
#define XB_XCNT(j)  (256  + 64 * (j))
#define XB_XSUB(j)  (1280 + 64 * (j))
#define XB_XGEN(j)  (2304 + 64 * (j))
#define XB_TOP      3328
#define XB_TOPGEN   3392
#define XCD_BAR_WORDS 3456
#define XB_SPIN_CAP (1u << 18)
__device__ __forceinline__ unsigned xb_ld(unsigned* p)              { return __hip_atomic_load(p, __ATOMIC_RELAXED, __HIP_MEMORY_SCOPE_AGENT); }
__device__ __forceinline__ unsigned xb_add(unsigned* p, unsigned v) { return __hip_atomic_fetch_add(p, v, __ATOMIC_RELAXED, __HIP_MEMORY_SCOPE_AGENT); }
__device__ __forceinline__ unsigned xb_xcc_id() { return (unsigned)__builtin_amdgcn_s_getreg((3 << 11) | 20) & 0xFu; }
#define XB_SPIN(cond, bar) do { unsigned _sp = 0; while (cond) { __builtin_amdgcn_s_sleep(1); \
    if ((++_sp & 255u) == 0u) { if (xb_ld(&(bar)[XB_TMO])) break; if (_sp > XB_SPIN_CAP) { atomicAdd(&(bar)[XB_TMO], 1u); break; } } } } while (0)
struct XcdBarrier { unsigned* bar; unsigned x; volatile LAS unsigned* st; };
__device__ __forceinline__ XcdBarrier xcd_barrier_post(unsigned* bar, volatile LAS unsigned* st) {
    XcdBarrier b; b.bar = bar; b.x = xb_xcc_id(); b.st = st;
    if (threadIdx.x == 0) (void)xb_add(&bar[XB_XCNT(b.x)], 1u);
    return b;
}
__device__ __forceinline__ void xcd_barrier_complete(unsigned* bar, unsigned x, unsigned& nloc, unsigned& nx) {
    const unsigned G = gridDim.x * gridDim.y * gridDim.z;
    unsigned sum, cnt, mine, sp = 0u;
    for (;;) {
        sum = 0u; cnt = 0u; mine = 0u;
#pragma unroll
        for (unsigned j = 0; j < 16; ++j) { const unsigned c = xb_ld(&bar[XB_XCNT(j)]); sum += c; cnt += (c > 0u) ? 1u : 0u; mine = (j == x) ? c : mine; }
        if (sum == G) break;
        __builtin_amdgcn_s_sleep(1);
        if ((++sp & 255u) == 0u) { if (xb_ld(&bar[XB_TMO])) break; if (sp > XB_SPIN_CAP) { atomicAdd(&bar[XB_TMO], 1u); break; } }
    }
    nloc = mine > 0u ? mine : 1u; nx = cnt > 0u ? cnt : 1u;
}
__device__ __forceinline__ void xcd_barrier(const XcdBarrier& b) {
    asm volatile("s_waitcnt vmcnt(0)" ::: "memory");
    __syncthreads();
    if (threadIdx.x == 0) {
        unsigned* bar = b.bar;
        __builtin_amdgcn_s_waitcnt(0);
        unsigned nloc = b.st[0], nx = b.st[1];
        if (nloc == 0u) { xcd_barrier_complete(bar, b.x, nloc, nx); b.st[0] = nloc; b.st[1] = nx; }
        const unsigned old = xb_add(&bar[XB_XSUB(b.x)], 1u);
        const unsigned gen = old / nloc;
        if (old + 1u == (gen + 1u) * nloc) {
            __builtin_amdgcn_fence(__ATOMIC_RELEASE, "agent");
            asm volatile("s_waitcnt vmcnt(0)" ::: "memory");
            const unsigned og = xb_add(&bar[XB_TOP], 1u);
            const unsigned tg = og / nx;
            if (og + 1u == (tg + 1u) * nx) xb_add(&bar[XB_TOPGEN], 1u);
            else XB_SPIN(xb_ld(&bar[XB_TOPGEN]) == tg, bar);
            __builtin_amdgcn_fence(__ATOMIC_ACQUIRE, "agent");
            xb_add(&bar[XB_XGEN(b.x)], 1u);
            asm volatile("s_waitcnt vmcnt(0)" ::: "memory");
        } else {
            XB_SPIN(xb_ld(&bar[XB_XGEN(b.x)]) == gen, bar);
            __builtin_amdgcn_fence(__ATOMIC_ACQUIRE, "agent");
            asm volatile("s_waitcnt vmcnt(0)" ::: "memory");
        }
    }
    __syncthreads();
}

struct Args {
    const float *x, *norm1_g, *w_in, *lq1, *lk1, *lq2, *lk2, *subln_g, *w_pool, *b_pool, *pool_scale, *w_out, *norm2_g, *router_w, *router_b,
                *w_gate, *b_gate, *w_up, *b_up, *w_down, *b_down, *final_g;
    float* out; unsigned char* ws; int ph_lo, ph_hi;
};

__global__ void __launch_bounds__(512, 2) mk_fwd(Args a) {
    extern __shared__ __attribute__((aligned(16))) unsigned char lds_raw[];
    LAS unsigned char* lds = (LAS unsigned char*)lds_raw;
    const int tid = threadIdx.x, lane = tid & 63; const int wave = __builtin_amdgcn_readfirstlane(tid >> 6);
    const int G = gridDim.x, bx = blockIdx.x; const int vcu = (G % 8 == 0) ? (bx % 8) * (G / 8) + bx / 8 : bx;
    unsigned char* ws = a.ws;
    unsigned* ctl = (unsigned*)(ws + WS_CTL);
    bf16_t* WIN = (bf16_t*)(ws + WS_WIN); bf16_t* WOUT = (bf16_t*)(ws + WS_WOUT);
    bf16_t* WD = (bf16_t*)(ws + WS_WD); bf16_t* WGU = (bf16_t*)(ws + WS_WGU); bf16_t* ACT = (bf16_t*)(ws + WS_ACT);
    bf16_t* XN = (bf16_t*)(ws + WS_XN); bf16_t* QKVU = (bf16_t*)(ws + WS_QKVU); bf16_t* MIX = (bf16_t*)(ws + WS_MIX); bf16_t* Y = (bf16_t*)(ws + WS_Y);
    int* TOKE = (int*)(ws + WS_TOKE); int* TOKP = (int*)(ws + WS_TOKP); int* LTOK = (int*)(ws + WS_LTOK); float* LGATE = (float*)(ws + WS_LGATE);
    float* x1 = a.out;
    LAS int* ldsx = (LAS int*)(lds + LDSX_OFF);
    const int lo = a.ph_lo, hi = a.ph_hi;
#define IN(k) (lo <= (k) && (k) < hi)
#if MK_N_LAUNCHES == 1
    if (tid < 2) ldsx[248 + tid] = 0;
    __syncthreads();
    const XcdBarrier gbar = xcd_barrier_post(ctl + CW_BAR, (volatile LAS unsigned*)(ldsx + 248));
#define GRID_BAR() do { xcd_barrier(gbar); } while (0)
#else
#define GRID_BAR() do { } while (0)
#endif
    const int gw = vcu * 8 + wave, NGW = G * 8;

    if (IN(0)) {
      for (int rep = 0; rep < REP0; ++rep) {
        LAS float* scr = (LAS float*)(lds + wave * 16384);
        constexpr int I_EXP = 96 * 512, I_IN = 16 * 48, I_OUT = 512, I_POOL = 512, NITEMS = I_EXP + I_IN + I_OUT + I_POOL;
        for (int it = gw; it < NITEMS; it += NGW) {
            int r = it;
            if (r < I_EXP) { const int mi = r >> 9, e = mi / 3, which = mi % 3, q = r & 511, kb = q >> 5, nb = q & 31, n0 = nb * 32;
                if (which == 2) transpose_item_fp8(a.w_down + (size_t)e * D * D, D, kb * 64, n0, (unsigned char*)WD + (size_t)e * D * D, D, n0, scr, lane);
                else transpose_item_fp8((which == 0 ? a.w_gate : a.w_up) + (size_t)e * D * D, D, kb * 64, n0, (unsigned char*)WGU + (size_t)e * 2048 * D, D, (n0 >> 7) * 256 + which * 128 + (n0 & 127), scr, lane);
                continue; }
            r -= I_EXP;
            if (r < I_IN) { const int kb = r / 48, nb = r % 48; transpose_item(a.w_in, NIN, kb * 64, nb * 32, WIN, D, nb * 32, scr, lane); continue; }
            r -= I_IN;
            if (r < I_OUT) { const int kb = r >> 5, nb = r & 31; transpose_item(a.w_out, D, kb * 64, nb * 32, WOUT, D, nb * 32, scr, lane); continue; }
            r -= I_OUT;
            { const int g = r >> 7, q = r & 127, kb = q >> 1, dh = q & 1; fold_pool_item(a.w_in, a.w_pool, WIN, g, kb * 16, dh * 64, lane); }
        }
        for (int m = gw; m < M; m += NGW) rms_row_to_bf16(a.x + (size_t)m * D, a.norm1_g, XN + (size_t)m * D, lane);
      }
        if (IN(1)) GRID_BAR();
    }

    if (IN(1)) {
        pg8::DenseSched S; S.init(M, NIN, D * 2, G, bx, WIN, REP1);
        pg8::EpiQkvu E{QKVU};
        pg8::gemm_phase<pg8::EpiQkvu, pg8::DenseSched, true, false>(lds, (const char*)XN, D * 2, S, E);
        if (IN(2)) GRID_BAR();
    }

    if (IN(2)) {
        float s1 = 0.f, s2 = 0.f;
        for (int i = 0; i < 64; ++i) { s1 += a.lq1[i] * a.lk1[i]; s2 += a.lq2[i] * a.lk2[i]; }
        const float lam = __expf(s1) - __expf(s2) + LAMBDA_INIT;
        for (int rep = 0; rep < REP2; ++rep) for (int p = vcu; p < 256; p += G) { const int bh = p >> 3, j = p & 7;
            att::attn_unit(bh >> 2, bh & 3, 15 - j, QKVU, MIX, lds, lam, a.subln_g);
            att::attn_unit(bh >> 2, bh & 3, j, QKVU, MIX, lds, lam, a.subln_g); }
        for (int rep = 0; rep < REPPOOL; ++rep) for (int st = gw; st < M / 8; st += NGW) pool_strip(st, QKVU, a.b_pool, a.pool_scale, MIX, lane);
        if (IN(3)) GRID_BAR();
    }

    if (IN(3)) {
        pg8::DenseSched S; S.init(M, D, D * 2, G, bx, WOUT, REP3);
        pg8::EpiResF32 E{a.x, x1};
        pg8::gemm_phase<pg8::EpiResF32, pg8::DenseSched, true, false>(lds, (const char*)MIX, D * 2, S, E);
        if (IN(4)) GRID_BAR();
    }

    if (IN(4)) {
      for (int rep = 0; rep < REP4; ++rep) {
        const bool dummy = rep + 1 < REP4;
        unsigned* cntp = ctl + CW_CNT + (dummy ? 32 : 0);
        int* LTOKw = dummy ? (int*)(ws + WS_ACT) : LTOK; float* LGATEw = dummy ? (float*)(ws + WS_ACT + 2 * MiB) : LGATE;
        int* TOKEw = dummy ? (int*)(ws + WS_ACT + 4 * MiB) : TOKE; int* TOKPw = dummy ? (int*)(ws + WS_ACT + 5 * MiB) : TOKP;
        __syncthreads();
        for (int it = tid; it < 1024 * 8; it += 512) { const int c = it >> 3, ch = it & 7; const f32x4 v = *(const f32x4*)(a.router_w + (size_t)c * NE + ch * 4);
            *(LAS f32x4*)(lds + (c ^ ((c >> 5) & 1)) * 128 + ((ch ^ ((c >> 2) & 7)) * 16)) = v; }
        if (tid < 32) ldsx[128 + tid] = 0;
        __syncthreads();
        LAS int* pend = (LAS int*)(lds + LDSX_OFF + 1024);
        LAS float* lgs = (LAS float*)(lds + LDSX_OFF + 5120) + wave * 96;
        unsigned char* H8 = (unsigned char*)XN;
        int nloc = 0;
        const int NP = M / 2;
        f32x4 na[4], nb[4];
        if (gw < NP) {
#pragma unroll
            for (int j = 0; j < 4; ++j) { na[j] = *((const f32x4*)(x1 + (size_t)(2 * gw) * D) + lane + 64 * j); nb[j] = *((const f32x4*)(x1 + (size_t)(2 * gw + 1) * D) + lane + 64 * j); }
        }
        const int sw = lane & 7;
        const int myexp = ((lane >> 5) & 1) * 16 + ((lane >> 4) & 1) * 8 + ((lane >> 3) & 1) * 4 + ((lane >> 2) & 1) * 2 + ((lane >> 1) & 1);
        const float myrb = a.router_b[myexp];
        for (int p = gw; p < NP; p += NGW, nloc += 2) {
            float ha[16], hb[16]; float ssa = 0.f, ssb = 0.f;
#pragma unroll
            for (int j = 0; j < 4; ++j) { ha[4 * j] = na[j].x; ha[4 * j + 1] = na[j].y; ha[4 * j + 2] = na[j].z; ha[4 * j + 3] = na[j].w; hb[4 * j] = nb[j].x; hb[4 * j + 1] = nb[j].y; hb[4 * j + 2] = nb[j].z; hb[4 * j + 3] = nb[j].w;
                ssa += (na[j].x * na[j].x + na[j].y * na[j].y) + (na[j].z * na[j].z + na[j].w * na[j].w); ssb += (nb[j].x * nb[j].x + nb[j].y * nb[j].y) + (nb[j].z * nb[j].z + nb[j].w * nb[j].w); }
            if (p + NGW < NP) {
#pragma unroll
                for (int j = 0; j < 4; ++j) { na[j] = *((const f32x4*)(x1 + (size_t)(2 * (p + NGW)) * D) + lane + 64 * j); nb[j] = *((const f32x4*)(x1 + (size_t)(2 * (p + NGW) + 1) * D) + lane + 64 * j); }
            }
#pragma unroll
            for (int o = 1; o < 64; o <<= 1) { ssa += __shfl_xor(ssa, o); ssb += __shfl_xor(ssb, o); }
            const float ra = rsqrtf(ssa * (1.f / D) + RMS_EPS), rb = rsqrtf(ssb * (1.f / D) + RMS_EPS);
#pragma unroll
            for (int j = 0; j < 4; ++j) { const f32x4 gg = *((const f32x4*)a.norm2_g + lane + 64 * j);
                ha[4 * j + 0] *= ra * gg.x; ha[4 * j + 1] *= ra * gg.y; ha[4 * j + 2] *= ra * gg.z; ha[4 * j + 3] *= ra * gg.w;
                hb[4 * j + 0] *= rb * gg.x; hb[4 * j + 1] *= rb * gg.y; hb[4 * j + 2] *= rb * gg.z; hb[4 * j + 3] *= rb * gg.w;
                *((unsigned*)(H8 + (size_t)(2 * p) * D) + lane + 64 * j) = pk4_fp8(clamp448(ha[4 * j + 0] * H_SCALE), clamp448(ha[4 * j + 1] * H_SCALE), clamp448(ha[4 * j + 2] * H_SCALE), clamp448(ha[4 * j + 3] * H_SCALE));
                *((unsigned*)(H8 + (size_t)(2 * p + 1) * D) + lane + 64 * j) = pk4_fp8(clamp448(hb[4 * j + 0] * H_SCALE), clamp448(hb[4 * j + 1] * H_SCALE), clamp448(hb[4 * j + 2] * H_SCALE), clamp448(hb[4 * j + 3] * H_SCALE)); }
            f32x2 la[16], lb[16];
#pragma unroll
            for (int e = 0; e < 16; ++e) { la[e] = (f32x2){0.f, 0.f}; lb[e] = (f32x2){0.f, 0.f}; }
#pragma unroll
            for (int q = 0; q < 16; ++q) { const int c = 4 * lane + 256 * (q >> 2) + (q & 3); const LAS unsigned char* rp = lds + (c ^ ((lane >> 3) & 1)) * 128;
                f32x4 w[8];
#pragma unroll
                for (int ch = 0; ch < 8; ++ch) w[ch] = *(const LAS f32x4*)(rp + ((ch ^ sw) * 16));
                const f32x2 a2 = (f32x2){ha[q], ha[q]}, b2 = (f32x2){hb[q], hb[q]};
#pragma unroll
                for (int ch = 0; ch < 8; ++ch) { const f32x2 wl = (f32x2){w[ch].x, w[ch].y}, wh = (f32x2){w[ch].z, w[ch].w};
                    la[2 * ch] = __builtin_elementwise_fma(wl, a2, la[2 * ch]); la[2 * ch + 1] = __builtin_elementwise_fma(wh, a2, la[2 * ch + 1]);
                    lb[2 * ch] = __builtin_elementwise_fma(wl, b2, lb[2 * ch]); lb[2 * ch + 1] = __builtin_elementwise_fma(wh, b2, lb[2 * ch + 1]); } }
            float logit[2];
#pragma unroll
            for (int rw = 0; rw < 2; ++rw) {
                float v32[32];
#pragma unroll
                for (int e = 0; e < 16; ++e) { v32[2 * e] = rw ? lb[e].x : la[e].x; v32[2 * e + 1] = rw ? lb[e].y : la[e].y; }
                float v16[16];
#pragma unroll
                for (int e = 0; e < 16; ++e) { const float mine = (lane & 32) ? v32[e + 16] : v32[e], oth = (lane & 32) ? v32[e] : v32[e + 16]; v16[e] = mine + __shfl_xor(oth, 32); }
                float v8[8];
#pragma unroll
                for (int e = 0; e < 8; ++e) { const float mine = (lane & 16) ? v16[e + 8] : v16[e], oth = (lane & 16) ? v16[e] : v16[e + 8]; v8[e] = mine + __shfl_xor(oth, 16); }
                float v4[4];
#pragma unroll
                for (int e = 0; e < 4; ++e) { const float mine = (lane & 8) ? v8[e + 4] : v8[e], oth = (lane & 8) ? v8[e] : v8[e + 4]; v4[e] = mine + __shfl_xor(oth, 8); }
                float v2[2];
#pragma unroll
                for (int e = 0; e < 2; ++e) { const float mine = (lane & 4) ? v4[e + 2] : v4[e], oth = (lane & 4) ? v4[e] : v4[e + 2]; v2[e] = mine + __shfl_xor(oth, 4); }
                float v1; { const float mine = (lane & 2) ? v2[1] : v2[0], oth = (lane & 2) ? v2[0] : v2[1]; v1 = mine + __shfl_xor(oth, 2); }
                v1 += __shfl_xor(v1, 1);
                logit[rw] = v1 + myrb;
                lgs[rw * 32 + myexp] = logit[rw];
            }
            asm volatile("s_waitcnt lgkmcnt(0)" ::: "memory");
#pragma unroll
            for (int rw = 0; rw < 2; ++rw) {
                int rank = 0;
#pragma unroll
                for (int c4 = 0; c4 < 8; ++c4) { const f32x4 t = *(const LAS f32x4*)(lgs + rw * 32 + c4 * 4);
#pragma unroll
                    for (int i = 0; i < 4; ++i) { const int eo = c4 * 4 + i; rank += (t[i] > logit[rw] || (t[i] == logit[rw] && eo < myexp)) ? 1 : 0; } }
                if (rank < 4 && (lane & 1) == 0) { lgs[64 + rw * 8 + rank * 2] = __int_as_float(myexp); lgs[64 + rw * 8 + rank * 2 + 1] = logit[rw]; }
            }
            asm volatile("s_waitcnt lgkmcnt(0)" ::: "memory");
            if (lane < 8) { const int rw = lane >> 2, k = lane & 3;
                const f32x4 s0 = *(const LAS f32x4*)(lgs + 64 + rw * 8), s1 = *(const LAS f32x4*)(lgs + 64 + rw * 8 + 4);
                const float e1 = __expf(s0.w - s0.y), e2 = __expf(s1.y - s0.y), e3 = __expf(s1.w - s0.y); const float inv = 1.0f / (1.0f + e1 + e2 + e3);
                const int e = __float_as_int(k == 0 ? s0.x : k == 1 ? s0.z : k == 2 ? s1.x : s1.z); const float gt = (k == 0 ? 1.0f : k == 1 ? e1 : k == 2 ? e2 : e3) * inv;
                const int rank = __hip_atomic_fetch_add((LAS int*)(ldsx + 128 + e), 1, __ATOMIC_RELAXED, __HIP_MEMORY_SCOPE_WORKGROUP);
                LAS int* pe = pend + ((wave * 8 + nloc + rw) * 4 + k) * 4; pe[0] = e; pe[1] = rank; pe[2] = __float_as_int(gt); pe[3] = 2 * p + rw; }
            asm volatile("s_waitcnt lgkmcnt(0)" ::: "memory");
        }
        if (lane == 0) ldsx[224 + wave] = nloc;
        __syncthreads();
        if (tid < 32) ldsx[192 + tid] = (int)atomicAdd(cntp + tid, (unsigned)ldsx[128 + tid]);
        __syncthreads();
        if (tid < 256) { const int w8 = tid >> 5, rem = tid & 31, nl = rem >> 2, k = rem & 3;
            if (nl < ldsx[224 + w8]) { LAS int* pe = pend + ((w8 * 8 + nl) * 4 + k) * 4; const int e = pe[0], pos = ldsx[192 + e] + pe[1], m = pe[3];
                LTOKw[(size_t)e * M + pos] = m; LGATEw[(size_t)e * M + pos] = __int_as_float(pe[2]); TOKEw[m * 4 + k] = e; TOKPw[m * 4 + k] = pos; } }
      }
        if (IN(5)) GRID_BAR();
    }

    if (IN(5) || IN(6) || IN(7)) {
        __syncthreads();
        if (tid < 32) ldsx[64 + tid] = (int)__hip_atomic_load(ctl + CW_CNT + tid, __ATOMIC_RELAXED, __HIP_MEMORY_SCOPE_AGENT);
        __syncthreads();
        if (tid == 0) { int acc = 0; for (int e = 0; e < NE; ++e) { ldsx[e] = acc; acc += (ldsx[64 + e] + 255) >> 8; } ldsx[NE] = acc; }
        __syncthreads();
    }

    if (IN(5)) {
        pg8::MoeSched S{ldsx, ldsx + 64, 8, vcu / (G / 8), vcu % (G / 8), D, (const char*)WGU, (size_t)2048 * D, LTOK, true};
        pg8::EpiSwiglu E{(unsigned char*)ACT, a.b_gate, a.b_up};
        for (int rep = 0; rep < REP5; ++rep) pg8::gemm_phase<pg8::EpiSwiglu, pg8::MoeSched, true, true>(lds, (const char*)XN, D, S, E);
        if (IN(6)) GRID_BAR();
    }

    if (IN(6)) {
        pg8::MoeSched S{ldsx, ldsx + 64, 4, vcu / (G / 8), vcu % (G / 8), DFF, (const char*)WD, (size_t)D * DFF, LTOK, false};
        pg8::EpiDown E{Y, a.b_down, LGATE, ldsx};
        for (int rep = 0; rep < REP6; ++rep) pg8::gemm_phase<pg8::EpiDown, pg8::MoeSched, true, true>(lds, (const char*)ACT, DFF, S, E);
        if (IN(7)) GRID_BAR();
    }

    if (IN(7)) {
      for (int rep = 0; rep < REP7; ++rep) {
        float* outp = (rep + 1 < REP7) ? (float*)(ws + WS_ACT) : a.out;
        for (int m = gw; m < M; m += NGW) {
            const bf16_t* yr[4];
#pragma unroll
            for (int k = 0; k < 4; ++k) { const int e = TOKE[m * 4 + k], pos = TOKP[m * 4 + k]; yr[k] = Y + ((size_t)ldsx[e] * 256 + pos) * D; }
            f32x4 v[4]; float ss = 0.f;
#pragma unroll
            for (int j = 0; j < 4; ++j) { v[j] = *((const f32x4*)(x1 + (size_t)m * D) + lane + 64 * j);
#pragma unroll
                for (int k = 0; k < 4; ++k) { const u32x2 yv = *((const u32x2*)yr[k] + lane + 64 * j);
                    v[j].x += __uint_as_float(yv.x << 16); v[j].y += __uint_as_float(yv.x & 0xffff0000u); v[j].z += __uint_as_float(yv.y << 16); v[j].w += __uint_as_float(yv.y & 0xffff0000u); }
                ss += (v[j].x * v[j].x + v[j].y * v[j].y) + (v[j].z * v[j].z + v[j].w * v[j].w); }
            const float rstd = rsqrtf(wave_sum(ss) * (1.f / D) + RMS_EPS);
#pragma unroll
            for (int j = 0; j < 4; ++j) { const f32x4 gg = *((const f32x4*)a.final_g + lane + 64 * j); *((f32x4*)(outp + (size_t)m * D) + lane + 64 * j) = v[j] * rstd * gg; }
        }
      }
    }
#undef IN
#undef GRID_BAR
}

extern "C" void kernel_launch(void* const* d_in, const int* in_sizes, int n_in, void* d_out, int out_size, void* d_ws, size_t ws_size, hipStream_t stream) {
    static int grid = 0;
    if (grid == 0) {
        if (n_in != 22 || in_sizes[0] != M * D || out_size != M * D || ws_size < WS_END) { fprintf(stderr, "kernel_launch: unexpected shapes / workspace (n_in %d, ws %zu)\n", n_in, ws_size); grid = -1; return; }
        int dev = 0, cus = 0, per_cu = 0;
        (void)hipGetDevice(&dev); (void)hipDeviceGetAttribute(&cus, hipDeviceAttributeMultiprocessorCount, dev);
        (void)hipFuncSetAttribute((const void*)mk_fwd, hipFuncAttributeMaxDynamicSharedMemorySize, LDS_BYTES);
        (void)hipOccupancyMaxActiveBlocksPerMultiprocessor(&per_cu, (const void*)mk_fwd, 512, LDS_BYTES);
        (void)hipGetLastError();
        if (per_cu < 1) { fprintf(stderr, "kernel_launch: occupancy query says %d blocks per CU\n", per_cu); grid = -1; return; }
        grid = cus;
        if (grid % 8 != 0) grid -= grid % 8;
    }
    if (grid < 0) return;
    (void)hipMemsetAsync((char*)d_ws + WS_CTL, 0, CTL_ZERO_BYTES, stream);
    Args a{};
    const float** f = (const float**)&a;
    for (int i = 0; i < 22; ++i) f[i] = (const float*)d_in[i];
    a.out = (float*)d_out; a.ws = (unsigned char*)d_ws;
#if MK_N_LAUNCHES == 1
    a.ph_lo = 0; a.ph_hi = 8;
    void* args[] = {&a};
    hipError_t e = hipLaunchCooperativeKernel((const void*)mk_fwd, dim3(grid), dim3(512), args, LDS_BYTES, stream);
    if (e != hipSuccess) fprintf(stderr, "cooperative launch failed: %s (grid %d)\n", hipGetErrorString(e), grid);
#else
    for (int p = 0; p < 8; ++p) { a.ph_lo = p; a.ph_hi = p + 1; hipLaunchKernelGGL(mk_fwd, dim3(grid), dim3(512), LDS_BYTES, stream, a); }
#endif
}
```

```cpp
#include <hip/hip_runtime.h>
#include <hip/hip_cooperative_groups.h>
#include <cstdio>
#include <cstdint>
namespace cg = cooperative_groups;

#ifndef MK_N_LAUNCHES
#define MK_N_LAUNCHES 1
#endif

#ifndef REP0
#define REP0 1
#endif
#ifndef REP1
#define REP1 1
#endif
#ifndef REP2
#define REP2 1
#endif
#ifndef REP3
#define REP3 1
#endif
#ifndef PROBE_SUFFIX
#define PROBE_SUFFIX -1
#endif
#ifndef REPPOOL
#define REPPOOL 1
#endif
#ifndef REP4
#define REP4 1
#endif
#ifndef REP7
#define REP7 1
#endif
#ifndef REP5
#define REP5 1
#endif
#ifndef REP6
#define REP6 1
#endif
#define LAS __attribute__((address_space(3)))
#define GAS __attribute__((address_space(1)))
typedef unsigned short bf16_t;
typedef short bf16x8 __attribute__((ext_vector_type(8)));
typedef short s16x4 __attribute__((ext_vector_type(4)));
typedef float f32x4 __attribute__((ext_vector_type(4)));
typedef float f32x2 __attribute__((ext_vector_type(2)));
typedef float f32x16 __attribute__((ext_vector_type(16)));
typedef unsigned u32x4 __attribute__((ext_vector_type(4)));
typedef unsigned u32x2 __attribute__((ext_vector_type(2)));
typedef __bf16 bf16x2_t __attribute__((ext_vector_type(2)));

constexpr int BATCH = 8, SEQ = 2048, D = 1024, M = BATCH * SEQ;
constexpr int NIN = 2048;
constexpr int NE = 32, TOPK = 4, DFF = 1024;
constexpr int NSLOT = M * TOPK;
constexpr int PADROWS = NSLOT + NE * 256;
constexpr float RMS_EPS = 1e-5f;
constexpr float QSCALE = 0.125f * 1.4426950408889634f;
constexpr float LAMBDA_INIT = 0.2f;

constexpr float W_SCALE = 64.0f, H_SCALE = 8.0f, ACT_SCALE = 4.0f;
constexpr float GU_DESCALE = 1.0f / (W_SCALE * H_SCALE), DN_DESCALE = 1.0f / (W_SCALE * ACT_SCALE);
constexpr size_t MiB = 1u << 20;
constexpr size_t WS_CTL = 0, CTL_ZERO_BYTES = 1 * MiB;
constexpr size_t WS_WIN = 1 * MiB;
constexpr size_t WS_WOUT = 5 * MiB;
constexpr size_t WS_WPOOL = 7 * MiB;
constexpr size_t WS_TOKE = 8 * MiB;
constexpr size_t WS_TOKP = WS_TOKE + 256 * 1024;
constexpr size_t WS_LTOK = 9 * MiB;
constexpr size_t WS_LGATE = 11 * MiB;
constexpr size_t WS_WD = 16 * MiB;
constexpr size_t WS_WGU = 80 * MiB;
constexpr size_t WS_ACT = 208 * MiB;
constexpr size_t WS_XN = 352 * MiB;
constexpr size_t WS_QKVU = 384 * MiB;
constexpr size_t WS_MIX = 448 * MiB;
constexpr size_t WS_Y = 352 * MiB;
constexpr size_t WS_END = 496 * MiB;
constexpr int CW_CNT = 64;
constexpr int CW_BAR = 4096;

constexpr int RING_BYTES = 131072;
constexpr int LDSX_OFF = RING_BYTES;
constexpr int LDS_BYTES = 147456;

__device__ __forceinline__ unsigned pk2(float lo, float hi) { f32x2 v = {lo, hi}; bf16x2_t b = __builtin_convertvector(v, bf16x2_t); return __builtin_bit_cast(unsigned, b); }
__device__ __forceinline__ unsigned pk4_fp8(float a, float b, float c, float d) { int w = 0; w = __builtin_amdgcn_cvt_pk_fp8_f32(a, b, w, false); w = __builtin_amdgcn_cvt_pk_fp8_f32(c, d, w, true); return (unsigned)w; }
__device__ __forceinline__ float clamp448(float v) { return fminf(fmaxf(v, -448.0f), 448.0f); }
__device__ __forceinline__ float bf2f(unsigned short h) { return __uint_as_float(((unsigned)h) << 16); }
__device__ __forceinline__ float wave_sum(float v) {
#pragma unroll
    for (int o = 1; o < 64; o <<= 1) v += __shfl_xor(v, o);
    return v;
}
__device__ __forceinline__ float wave_max(float v) {
#pragma unroll
    for (int o = 1; o < 64; o <<= 1) v = fmaxf(v, __shfl_xor(v, o));
    return v;
}
__device__ __forceinline__ int wave_min_i(int v) {
#pragma unroll
    for (int o = 1; o < 64; o <<= 1) { int w = __shfl_xor(v, o); v = w < v ? w : v; }
    return v;
}

namespace pg8 {
constexpr int BM = 256, BK = 64, HALF = 128, HTB = HALF * BK * 2, STAGE_BYTES = 8 * HTB;
__device__ __forceinline__ int lds_byte(int r, int c) { const int st = (r >> 4) * 2 + (c >> 5), rr = r & 15, cc = c & 31, ob = rr * 64 + cc * 2; return st * 1024 + (ob ^ (((ob >> 9) & 1) << 5)); }
__device__ __forceinline__ void stage_rc(int b, int& R, int& C) { const int st = b / 1024, sb = b % 1024, swz = sb ^ (((sb >> 9) & 1) << 5); R = (st >> 1) * 16 + swz / 64; C = (st & 1) * 32 + (swz % 64) / 2; }
__device__ __forceinline__ int perm32(int rho) { const int n = rho >> 4, i = rho & 15; return 8 * (i >> 2) + 4 * n + (i & 3); }

struct Unit { int pm, pn, e; unsigned a00, a01, a10, a11; const char* B; };

typedef int i32x4 __attribute__((ext_vector_type(4)));
typedef int i32x8 __attribute__((ext_vector_type(8)));
__device__ __forceinline__ i32x8 cat8(bf16x8 lo, bf16x8 hi) { return __builtin_shufflevector(__builtin_bit_cast(i32x4, lo), __builtin_bit_cast(i32x4, hi), 0, 1, 2, 3, 4, 5, 6, 7); }
template <class Epi, class Sched, bool ALIGN_EPI, bool FP8>
__device__ __forceinline__ void gemm_phase(LAS unsigned char* lds, const char* A, const int Kb, const Sched& S, const Epi& E) {
    const int tid = threadIdx.x, wid = __builtin_amdgcn_readfirstlane(tid >> 6), lane = tid & 63, wr = wid >> 2, wc = wid & 3, fr = lane & 15, fq = lane >> 4;
    int nt = Kb / 128; asm volatile("" : "+s"(nt));
    int R0, C0, R1, C1; stage_rc(tid * 16, R0, C0); stage_rc(tid * 16 + 8192, R1, C1);
    unsigned voffB[2];
    { const int Rb0 = Epi::PERM ? ((R0 & ~31) + perm32(R0 & 31)) : R0, Rb1 = Epi::PERM ? ((R1 & ~31) + perm32(R1 & 31)) : R1;
      voffB[0] = (unsigned)(Rb0 * Kb + C0 * 2); voffB[1] = (unsigned)(Rb1 * Kb + C1 * 2); }
    const size_t kstep = (size_t)(BK * 2);
    const size_t hstep = (size_t)HALF * Kb;
    const unsigned ldsw = (unsigned)wid * 1024u;
    const int aoff = lds_byte(wr * 64 + fr, fq * 8), boff = lds_byte(wc * 32 + fr, fq * 8);
#define PG8_SA(b, h) (((b) * 2 + (h)) * HTB)
#define PG8_SB(b, h) ((4 + (b) * 2 + (h)) * HTB)
#define PG8_STAGEB(bufoff, gbase) do { _Pragma("unroll") for (int _i = 0; _i < 2; ++_i) \
        __builtin_amdgcn_global_load_lds((const unsigned*)((const char*)(gbase) + voffB[_i]), (LAS unsigned*)(lds + (bufoff) + ldsw + _i * 8192), 16, 0, 0); } while (0)
#define PG8_STAGEA(bufoff, kb, o0, o1) do { \
        __builtin_amdgcn_global_load_lds((const unsigned*)(A + (size_t)(o0) + (kb)), (LAS unsigned*)(lds + (bufoff) + ldsw), 16, 0, 0); \
        __builtin_amdgcn_global_load_lds((const unsigned*)(A + (size_t)(o1) + (kb)), (LAS unsigned*)(lds + (bufoff) + ldsw + 8192), 16, 0, 0); } while (0)
#define PG8_LDA(dst, b, h) do { _Pragma("unroll") for (int m = 0; m < 4; ++m) { const i32x4 lo_ = *(const LAS i32x4*)(lds + PG8_SA(b, h) + aoff + m * 2048), hi_ = *(const LAS i32x4*)(lds + PG8_SA(b, h) + aoff + m * 2048 + 1024); \
        dst[m] = __builtin_shufflevector(lo_, hi_, 0, 1, 2, 3, 4, 5, 6, 7); } } while (0)
#define PG8_LDB(dst, b, h) do { _Pragma("unroll") for (int n = 0; n < 2; ++n) { const i32x4 lo_ = *(const LAS i32x4*)(lds + PG8_SB(b, h) + boff + n * 2048), hi_ = *(const LAS i32x4*)(lds + PG8_SB(b, h) + boff + n * 2048 + 1024); \
        dst[n] = __builtin_shufflevector(lo_, hi_, 0, 1, 2, 3, 4, 5, 6, 7); } } while (0)
#define PG8_LO(v) __builtin_bit_cast(bf16x8, __builtin_shufflevector(v, v, 0, 1, 2, 3))
#define PG8_HI(v) __builtin_bit_cast(bf16x8, __builtin_shufflevector(v, v, 4, 5, 6, 7))
#define PG8_MMA(ai, bj, At, Bt) do { __builtin_amdgcn_s_setprio(1); if constexpr (FP8) { _Pragma("unroll") for (int m = 0; m < 4; ++m) _Pragma("unroll") for (int n = 0; n < 2; ++n) \
        asm volatile("s_nop 1\n\tv_mfma_f32_16x16x128_f8f6f4 %0, %1, %2, %0" : "+v"(acc[ai][bj][m][n]) : "v"(Bt[n]), "v"(At[m])); } else { \
        _Pragma("unroll") for (int m = 0; m < 4; ++m) _Pragma("unroll") for (int n = 0; n < 2; ++n) { \
        acc[ai][bj][m][n] = __builtin_amdgcn_mfma_f32_16x16x32_bf16(PG8_LO(Bt[n]), PG8_LO(At[m]), acc[ai][bj][m][n], 0, 0, 0); \
        acc[ai][bj][m][n] = __builtin_amdgcn_mfma_f32_16x16x32_bf16(PG8_HI(Bt[n]), PG8_HI(At[m]), acc[ai][bj][m][n], 0, 0, 0); } } __builtin_amdgcn_s_setprio(0); } while (0)
#define PG8_WAIT_V(n) asm volatile("s_waitcnt vmcnt(" #n ")" ::: "memory")
#define PG8_WAIT_L(n) asm volatile("s_waitcnt lgkmcnt(" #n ")" ::: "memory")
#define PG8_BAR __builtin_amdgcn_s_barrier()
#define PG8_SCHED __builtin_amdgcn_sched_barrier(0)
    Unit cur, nxt; int ui = 0;
    if (!S.next(0, cur, R0, C0, R1, C1)) return;
    f32x4 acc[2][2][4][2];
#pragma unroll
    for (int a = 0; a < 2; ++a)
#pragma unroll
        for (int b = 0; b < 2; ++b)
#pragma unroll
            for (int m = 0; m < 4; ++m)
#pragma unroll
                for (int n = 0; n < 2; ++n) acc[a][b][m][n] = (f32x4){0.f, 0.f, 0.f, 0.f};
    i32x8 At[4], B0[2], B1[2];
    const char* cB = cur.B;
    PG8_STAGEB(PG8_SB(0, 0), cB); PG8_STAGEB(PG8_SB(0, 1), cB + hstep); PG8_STAGEA(PG8_SA(0, 0), 0, cur.a00, cur.a01); PG8_STAGEA(PG8_SA(0, 1), 0, cur.a10, cur.a11);
    if (wr == 1) PG8_BAR;
    PG8_WAIT_V(2); PG8_BAR;
    PG8_STAGEB(PG8_SB(1, 0), cB + kstep); PG8_STAGEA(PG8_SA(1, 0), kstep, cur.a00, cur.a01); PG8_STAGEB(PG8_SB(1, 1), cB + hstep + kstep);
    PG8_WAIT_V(6); PG8_BAR;
    for (;;) {
        const bool has_next = S.next(ui + 1, nxt, R0, C0, R1, C1);
        if (!has_next) nxt = cur;
        const char* nB = nxt.B;
#pragma unroll 1
        for (int t = 0; t < nt; t += 2) {
            const bool last = (t == nt - 2);
            const size_t k1 = (size_t)(t + 1) * kstep;
            const size_t k2 = last ? 0 : (size_t)(t + 2) * kstep, k3 = k2 + kstep;
            const char* b2 = last ? nB : cB + (size_t)(t + 2) * kstep; const char* b3 = b2 + kstep;
            const unsigned s00 = last ? nxt.a00 : cur.a00, s01 = last ? nxt.a01 : cur.a01, s10 = last ? nxt.a10 : cur.a10, s11 = last ? nxt.a11 : cur.a11;
            PG8_LDB(B0, 0, 0); PG8_LDB(B1, 0, 1); PG8_SCHED; PG8_LDA(At, 0, 0); PG8_STAGEA(PG8_SA(1, 1), k1, cur.a10, cur.a11);
            PG8_WAIT_V(8); PG8_WAIT_L(0); PG8_BAR; PG8_MMA(0, 0, At, B0); PG8_MMA(0, 1, At, B1); PG8_BAR; PG8_SCHED;
            PG8_LDA(At, 0, 1); PG8_STAGEB(PG8_SB(0, 0), b2); PG8_STAGEB(PG8_SB(0, 1), b2 + hstep); PG8_STAGEA(PG8_SA(0, 0), k2, s00, s01);
            PG8_WAIT_V(8); PG8_WAIT_L(0); PG8_BAR; PG8_MMA(1, 0, At, B0); PG8_MMA(1, 1, At, B1); PG8_BAR; PG8_SCHED;
            PG8_LDB(B0, 1, 0); PG8_LDB(B1, 1, 1); PG8_SCHED; PG8_LDA(At, 1, 0); PG8_STAGEA(PG8_SA(0, 1), k2, s10, s11);
            PG8_WAIT_V(8); PG8_WAIT_L(0); PG8_BAR; PG8_MMA(0, 0, At, B0); PG8_MMA(0, 1, At, B1); PG8_BAR; PG8_SCHED;
            PG8_LDA(At, 1, 1); PG8_STAGEB(PG8_SB(1, 0), b3); PG8_STAGEB(PG8_SB(1, 1), b3 + hstep); PG8_STAGEA(PG8_SA(1, 0), k3, s00, s01);
            PG8_WAIT_V(8); PG8_WAIT_L(0); PG8_BAR; PG8_MMA(1, 0, At, B0); PG8_MMA(1, 1, At, B1); PG8_BAR; PG8_SCHED;
        }
        if constexpr (ALIGN_EPI) { if (wr == 0) PG8_BAR; }
        if constexpr (FP8) { PG8_SCHED; asm volatile("s_nop 15\n\ts_nop 7" ::: "memory"); PG8_SCHED; }
        E(acc, cur, wr, wc, fr, fq);
        if (!has_next) break;
#pragma unroll
        for (int a = 0; a < 2; ++a)
#pragma unroll
            for (int b = 0; b < 2; ++b)
#pragma unroll
                for (int m = 0; m < 4; ++m)
#pragma unroll
                    for (int n = 0; n < 2; ++n) acc[a][b][m][n] = (f32x4){0.f, 0.f, 0.f, 0.f};
        cur = nxt; cB = nB; ++ui;
        if constexpr (ALIGN_EPI) { if (wr == 1) PG8_BAR; }
    }
    PG8_WAIT_V(0);
    if constexpr (!ALIGN_EPI) { if (wr == 0) PG8_BAR; }
    PG8_BAR;
#undef PG8_SA
#undef PG8_SB
#undef PG8_STAGEA
#undef PG8_STAGEB
#undef PG8_LDA
#undef PG8_LDB
#undef PG8_LO
#undef PG8_HI
#undef PG8_MMA
#undef PG8_WAIT_V
#undef PG8_WAIT_L
#undef PG8_BAR
#undef PG8_SCHED
}

struct DenseSched {
    int nM, nN, nwg, G, c, Kb, dup; const char* Bt;
    __device__ __forceinline__ void init(int Mr, int N, int Kb_, int G_, int c_, const void* Bt_, int dup_) { nM = Mr / BM; nN = N / BM; nwg = nM * nN; G = G_; c = c_; Kb = Kb_; Bt = (const char*)Bt_; dup = dup_; }
    __device__ __forceinline__ bool next(int i, Unit& u, int R0, int C0, int R1, int C1) const {
        const long L = (long)(i / dup) * G + c; if (L >= nwg) return false;
        int wgid = (int)L; { const int q = nwg / 8, r = nwg % 8, xcd = wgid % 8, off = wgid / 8; wgid = (xcd < r ? xcd * (q + 1) : r * (q + 1) + (xcd - r) * q) + off; }
        const int WGM = 8, nig = WGM * nN, gid = wgid / nig, fm = gid * WGM, gsz = (nM - fm) < WGM ? (nM - fm) : WGM;
        u.pm = fm + ((wgid % nig) % gsz); u.pn = (wgid % nig) / gsz; u.e = 0;
        const unsigned rb = (unsigned)u.pm * 256u;
        u.a00 = (rb + R0) * Kb + C0 * 2; u.a01 = (rb + R1) * Kb + C1 * 2; u.a10 = (rb + 128 + R0) * Kb + C0 * 2; u.a11 = (rb + 128 + R1) * Kb + C1 * 2;
        u.B = Bt + (size_t)u.pn * 256 * Kb; return true;
    }
};
struct MoeSched {
    const LAS int* tp; const LAS int* cnt; int NT; int xcd, j; int Kb; const char* W; size_t wstride; const int* ltok; bool gather;
    __device__ __forceinline__ int rd(const LAS int* p) const { return __builtin_amdgcn_readfirstlane(*p); }
    __device__ __forceinline__ bool next(int i, Unit& u, int R0, int C0, int R1, int C1) const {
        const int U = rd(tp + NE) * NT; const int lo = (int)(((long)xcd * U) / 8), hi = (int)(((long)(xcd + 1) * U) / 8);
        const int L = lo + i * 32 + j; if (L >= hi) return false;
        int e = 0;
        for (int q = 1; q < NE; ++q) e = (L >= rd(tp + q) * NT) ? q : e;
        const int tpe = rd(tp + e), nte = rd(tp + e + 1) - tpe, r = L - tpe * NT, pn = r / nte, mt = r % nte;
        u.e = e; u.pn = pn; u.pm = tpe + mt;
        if (gather) {
            const int ce = rd(cnt + e); const int* lt = ltok + (size_t)e * M;
            const int i00 = mt * 256 + R0, i01 = mt * 256 + R1, i10 = i00 + 128, i11 = i01 + 128;
            const unsigned t00 = i00 < ce ? (unsigned)lt[i00] : 0u, t01 = i01 < ce ? (unsigned)lt[i01] : 0u, t10 = i10 < ce ? (unsigned)lt[i10] : 0u, t11 = i11 < ce ? (unsigned)lt[i11] : 0u;
            u.a00 = t00 * Kb + C0 * 2; u.a01 = t01 * Kb + C1 * 2; u.a10 = t10 * Kb + C0 * 2; u.a11 = t11 * Kb + C1 * 2;
        } else {
            const unsigned rb = (unsigned)u.pm * 256u;
            u.a00 = (rb + R0) * Kb + C0 * 2; u.a01 = (rb + R1) * Kb + C1 * 2; u.a10 = (rb + 128 + R0) * Kb + C0 * 2; u.a11 = (rb + 128 + R1) * Kb + C1 * 2;
        }
        u.B = W + (size_t)e * wstride + (size_t)pn * 256 * Kb; return true;
    }
};

struct EpiQkvu {
    static constexpr bool PERM = true; bf16_t* O;
    __device__ __forceinline__ void operator()(const f32x4 (&acc)[2][2][4][2], const Unit& u, int wr, int wc, int fr, int fq) const {
        const int row0 = u.pm * BM + wr * 64 + fr, col0 = u.pn * BM + wc * 32 + 8 * fq; const float sc = (u.pn < 2) ? QSCALE : 1.f;
#pragma unroll
        for (int ai = 0; ai < 2; ++ai)
#pragma unroll
            for (int m = 0; m < 4; ++m) { bf16_t* rowp = O + (size_t)(row0 + ai * HALF + m * 16) * NIN + col0;
#pragma unroll
                for (int bj = 0; bj < 2; ++bj) { const f32x4 v0 = acc[ai][bj][m][0] * sc, v1 = acc[ai][bj][m][1] * sc;
                    u32x4 w; w.x = pk2(v0[0], v0[1]); w.y = pk2(v0[2], v0[3]); w.z = pk2(v1[0], v1[1]); w.w = pk2(v1[2], v1[3]);
                    *(u32x4*)(rowp + bj * HALF) = w; } }
    }
};
struct EpiResF32 {
    static constexpr bool PERM = false; const float* base; float* out;
    __device__ __forceinline__ void operator()(const f32x4 (&acc)[2][2][4][2], const Unit& u, int wr, int wc, int fr, int fq) const {
        const int col0 = u.pn * BM + wc * 32 + 4 * fq;
#pragma unroll
        for (int ai = 0; ai < 2; ++ai)
#pragma unroll
            for (int m = 0; m < 4; ++m) { const size_t off = (size_t)(u.pm * BM + ai * HALF + wr * 64 + m * 16 + fr) * D + col0;
#pragma unroll
                for (int bj = 0; bj < 2; ++bj)
#pragma unroll
                    for (int n = 0; n < 2; ++n) { const f32x4 bs = *(const f32x4*)(base + off + bj * HALF + n * 16); *(f32x4*)(out + off + bj * HALF + n * 16) = bs + acc[ai][bj][m][n]; } }
    }
};
struct EpiSwiglu {
    static constexpr bool PERM = true; unsigned char* ACT; const float* bg; const float* bu;
    __device__ __forceinline__ void operator()(const f32x4 (&acc)[2][2][4][2], const Unit& u, int wr, int wc, int fr, int fq) const {
        const int row0 = u.pm * BM + wr * 64 + fr, col0 = u.pn * 128 + wc * 32 + 8 * fq;
        f32x4 g4[2], u4[2];
#pragma unroll
        for (int n = 0; n < 2; ++n) { g4[n] = *(const f32x4*)(bg + (size_t)u.e * DFF + col0 + 4 * n); u4[n] = *(const f32x4*)(bu + (size_t)u.e * DFF + col0 + 4 * n); }
#pragma unroll
        for (int ai = 0; ai < 2; ++ai)
#pragma unroll
            for (int m = 0; m < 4; ++m) { float a[8];
#pragma unroll
                for (int n = 0; n < 2; ++n)
#pragma unroll
                    for (int j = 0; j < 4; ++j) { const float g = fminf(acc[ai][0][m][n][j] * GU_DESCALE + g4[n][j], 7.0f); const float up = fminf(fmaxf(acc[ai][1][m][n][j] * GU_DESCALE + u4[n][j], -7.0f), 7.0f);
                        const float sg = __builtin_amdgcn_rcpf(1.0f + __builtin_amdgcn_exp2f(-1.702f * 1.4426950408889634f * g)); a[n * 4 + j] = g * sg * (up + 1.0f) * ACT_SCALE; }
                u32x2 w; w.x = pk4_fp8(a[0], a[1], a[2], a[3]); w.y = pk4_fp8(a[4], a[5], a[6], a[7]);
                *(u32x2*)(ACT + (size_t)(row0 + ai * HALF + m * 16) * DFF + col0) = w; }
    }
};
struct EpiDown {
    static constexpr bool PERM = true; bf16_t* Y; const float* bd; const float* lgate; const LAS int* tp;
    __device__ __forceinline__ void operator()(const f32x4 (&acc)[2][2][4][2], const Unit& u, int wr, int wc, int fr, int fq) const {
        const int mt = u.pm - tp[u.e]; const int row0 = u.pm * BM + wr * 64 + fr, col0 = u.pn * BM + wc * 32 + 8 * fq;
        const float* lg = lgate + (size_t)u.e * M + mt * 256 + wr * 64 + fr;
        f32x4 bv[2][2];
#pragma unroll
        for (int bj = 0; bj < 2; ++bj)
#pragma unroll
            for (int n = 0; n < 2; ++n) bv[bj][n] = *(const f32x4*)(bd + (size_t)u.e * D + col0 + bj * HALF + 4 * n);
#pragma unroll
        for (int ai = 0; ai < 2; ++ai)
#pragma unroll
            for (int m = 0; m < 4; ++m) { const float gt = lg[ai * HALF + m * 16]; bf16_t* rowp = Y + (size_t)(row0 + ai * HALF + m * 16) * D + col0;
#pragma unroll
                for (int bj = 0; bj < 2; ++bj) { const f32x4 v0 = (acc[ai][bj][m][0] * DN_DESCALE + bv[bj][0]) * gt, v1 = (acc[ai][bj][m][1] * DN_DESCALE + bv[bj][1]) * gt;
                    u32x4 w; w.x = pk2(v0[0], v0[1]); w.y = pk2(v0[2], v0[3]); w.z = pk2(v1[0], v1[1]); w.w = pk2(v1[2], v1[3]);
                    *(u32x4*)(rowp + bj * HALF) = w; } }
    }
};
}

namespace att {
__device__ __forceinline__ int crow(int r, int hi) { return (r & 3) + 8 * (r >> 2) + 4 * hi; }
__device__ __forceinline__ s16x4 vtr(const LAS unsigned char* p) { typedef short v4 __attribute__((ext_vector_type(4))); return __builtin_bit_cast(s16x4, __builtin_amdgcn_ds_read_tr16_b64_v4i16((LAS v4*)p)); }

constexpr int CONV_ITEMS = 96 * 512;
struct ConvCtx { const float* wg; const float* wu; const float* wd; unsigned char* WGU8; unsigned char* WD8; int next, stride, pending; LAS unsigned char* scr; };
__device__ __forceinline__ void conv_decode(const ConvCtx& c, int it, const float*& src, unsigned char*& dst, int& drow0, int& k0) {
    const int mi = it >> 9, e = mi / 3, which = mi - 3 * e, q = it & 511, kb = q >> 5, n0 = (q & 31) * 32;
    k0 = kb * 64;
    src = (which == 0 ? c.wg : which == 1 ? c.wu : c.wd) + (size_t)e * D * D + (size_t)k0 * D + n0;
    if (which == 2) { dst = c.WD8 + (size_t)e * D * D; drow0 = n0; } else { dst = c.WGU8 + (size_t)e * 2048 * D; drow0 = (n0 >> 7) * 256 + which * 128 + (n0 & 127); }
}
__device__ __forceinline__ void conv_issue(ConvCtx& c, int lane) {
    if (c.next >= CONV_ITEMS) return;
    const float* src; unsigned char* dst; int drow0, k0; conv_decode(c, c.next, src, dst, drow0, k0);
#pragma unroll
    for (int i = 0; i < 8; ++i) { const int k = i * 8 + (lane >> 3), p = lane & 7, c4 = (p - 2 * (k >> 4)) & 7;
        __builtin_amdgcn_global_load_lds((const unsigned*)(src + (size_t)k * D + 4 * c4), (LAS unsigned*)(c.scr + i * 1024), 16, 0, 0); }
    c.pending = c.next; c.next += c.stride;
}
__device__ __forceinline__ void conv_finish(ConvCtx& c, int lane) {
    if (c.pending < 0) return;
    const float* src; unsigned char* dst; int drow0, k0; conv_decode(c, c.pending, src, dst, drow0, k0);
    const LAS float* sf = (const LAS float*)c.scr; const int kc = lane & 3;
#pragma unroll
    for (int j = 0; j < 2; ++j) { const int n = (lane >> 2) + 16 * j, c4 = n >> 2; float v[16];
#pragma unroll
        for (int i = 0; i < 16; ++i) v[i] = clamp448(sf[((16 * kc + i) * 8 + ((c4 + 2 * kc) & 7)) * 4 + (n & 3)] * W_SCALE);
        u32x4 o; o.x = pk4_fp8(v[0], v[1], v[2], v[3]); o.y = pk4_fp8(v[4], v[5], v[6], v[7]); o.z = pk4_fp8(v[8], v[9], v[10], v[11]); o.w = pk4_fp8(v[12], v[13], v[14], v[15]);
        *(u32x4*)(dst + (size_t)(drow0 + n) * D + k0 + 16 * kc) = o; }
    asm volatile("s_waitcnt lgkmcnt(0)" ::: "memory");
    c.pending = -1;
}

__device__ __forceinline__ void attn_unit(int b, int h, int qb, const bf16_t* QKVU, bf16_t* MIX, LAS unsigned char* lds, float lam, const float* subln_g, ConvCtx& cc) {
    const int tid = threadIdx.x, lane = tid & 63, r32 = lane & 31, hi = lane >> 5; const int wid = __builtin_amdgcn_readfirstlane(tid >> 6);
    const int map = wid >> 2, wq = wid & 3;
    const long rowbase = (long)b * SEQ; const int q0 = qb * 128;
    const int NT = 2 * qb + 2;
    const bf16_t* Qp = QKVU + (size_t)(rowbase + q0 + wq * 32 + r32) * NIN + h * 128 + map * 64 + hi * 8;
    bf16x8 qr[4];
#pragma unroll
    for (int d0 = 0; d0 < 4; ++d0) qr[d0] = *(const bf16x8*)(Qp + d0 * 16);
    const bf16_t* ksrc[2]; const bf16_t* vsrc[2];
#pragma unroll
    for (int i = 0; i < 2; ++i) { const int p = 2 * wid + i;
        ksrc[i] = QKVU + (size_t)(rowbase + lane) * NIN + 512 + h * 128 + (p >> 3) * 64 + (p & 7) * 8;
        vsrc[i] = QKVU + (size_t)(rowbase + 16 * (p & 3) + (lane >> 2)) * NIN + 1024 + h * 128 + (p >> 2) * 32 + (lane & 3) * 8; }
#define ATT_DMA(t, buf) do { _Pragma("unroll") for (int _i = 0; _i < 2; ++_i) { \
        __builtin_amdgcn_global_load_lds((const unsigned*)(ksrc[_i] + (size_t)(t) * 64 * NIN), (LAS unsigned*)(lds + (buf) * 32768 + (2 * wid + _i) * 1024), 16, 0, 0); \
        __builtin_amdgcn_global_load_lds((const unsigned*)(vsrc[_i] + (size_t)(t) * 64 * NIN), (LAS unsigned*)(lds + (buf) * 32768 + 16384 + (2 * wid + _i) * 1024), 16, 0, 0); } } while (0)
    float m_run = -INFINITY, l_run = 0.f;
    f32x16 o[4];
#pragma unroll
    for (int d0 = 0; d0 < 4; ++d0) o[d0] = f32x16{};
    const int qabs = q0 + wq * 32 + r32;
    ATT_DMA(0, 0);
    for (int t = 0; t < NT; ++t) {
        __syncthreads();
        if (t + 1 < NT) ATT_DMA(t + 1, (t + 1) & 1);
        conv_finish(cc, lane); conv_issue(cc, lane);
        if (64 * t <= q0 + wq * 32 + 31) {
            const LAS unsigned char* Kb = lds + (t & 1) * 32768 + map * 8192 + hi * 1024 + r32 * 16;
            const LAS unsigned char* Vb = lds + (t & 1) * 32768 + 16384 + ((lane >> 4) & 1) * 32 + (lane & 3) * 8 + (4 * hi + ((lane & 15) >> 2)) * 64;
            f32x16 p0 = f32x16{}, p1 = f32x16{};
#pragma unroll
            for (int d0 = 0; d0 < 4; ++d0) {
                const bf16x8 k0 = *(const LAS bf16x8*)(Kb + d0 * 2048), k1 = *(const LAS bf16x8*)(Kb + d0 * 2048 + 512);
                p0 = __builtin_amdgcn_mfma_f32_32x32x16_bf16(k0, qr[d0], p0, 0, 0, 0);
                p1 = __builtin_amdgcn_mfma_f32_32x32x16_bf16(k1, qr[d0], p1, 0, 0, 0);
            }
            if (t >= NT - 2) {
#pragma unroll
                for (int r = 0; r < 16; ++r) { const int kv = 64 * t + crow(r, hi); if (kv > qabs) p0[r] = -INFINITY; if (kv + 32 > qabs) p1[r] = -INFINITY; }
            }
            float rm = fmaxf(p0[0], p1[0]);
#pragma unroll
            for (int r = 1; r < 16; ++r) rm = fmaxf(rm, fmaxf(p0[r], p1[r]));
            { auto rr = __builtin_amdgcn_permlane32_swap(__float_as_uint(rm), __float_as_uint(rm), false, false); rm = fmaxf(__uint_as_float(rr[0]), __uint_as_float(rr[1])); }
            const float mnew = fmaxf(m_run, rm);
            const float f = __builtin_amdgcn_exp2f(m_run - mnew);
            m_run = mnew;
            float ls = 0.f;
#pragma unroll
            for (int r = 0; r < 16; ++r) { p0[r] = __builtin_amdgcn_exp2f(p0[r] - mnew); p1[r] = __builtin_amdgcn_exp2f(p1[r] - mnew); ls += p0[r] + p1[r]; }
            l_run = l_run * f + ls;
            if (!__all(f == 1.0f)) {
#pragma unroll
                for (int d0 = 0; d0 < 4; ++d0)
#pragma unroll
                    for (int r = 0; r < 16; ++r) o[d0][r] *= f;
            }
            bf16x8 pa[4];
#pragma unroll
            for (int s = 0; s < 2; ++s) {
                u32x4 w0, w1;
                w0.x = pk2(p0[8 * s + 0], p0[8 * s + 1]); w0.y = pk2(p0[8 * s + 2], p0[8 * s + 3]); w0.z = pk2(p0[8 * s + 4], p0[8 * s + 5]); w0.w = pk2(p0[8 * s + 6], p0[8 * s + 7]);
                w1.x = pk2(p1[8 * s + 0], p1[8 * s + 1]); w1.y = pk2(p1[8 * s + 2], p1[8 * s + 3]); w1.z = pk2(p1[8 * s + 4], p1[8 * s + 5]); w1.w = pk2(p1[8 * s + 6], p1[8 * s + 7]);
                pa[s] = __builtin_bit_cast(bf16x8, w0); pa[2 + s] = __builtin_bit_cast(bf16x8, w1);
            }
#pragma unroll
            for (int d0 = 0; d0 < 4; ++d0) {
#pragma unroll
                for (int ks = 0; ks < 4; ++ks) {
                    const s16x4 lo = vtr(Vb + (d0 * 4 + ks) * 1024), hh = vtr(Vb + (d0 * 4 + ks) * 1024 + 512);
                    const bf16x8 vf = (bf16x8){lo[0], lo[1], lo[2], lo[3], hh[0], hh[1], hh[2], hh[3]};
                    o[d0] = __builtin_amdgcn_mfma_f32_32x32x16_bf16(vf, pa[ks], o[d0], 0, 0, 0);
                }
            }
        }
    }
#undef ATT_DMA
    { auto rr = __builtin_amdgcn_permlane32_swap(__float_as_uint(l_run), __float_as_uint(l_run), false, false); l_run = __uint_as_float(rr[0]) + __uint_as_float(rr[1]); }
    const float rl = 1.0f / l_run;
    __syncthreads();
    conv_finish(cc, lane);
    LAS float* xs = (LAS float*)lds + wq * 4096 + lane;
    if (map == 1) {
#pragma unroll
        for (int d0 = 0; d0 < 4; ++d0)
#pragma unroll
            for (int r = 0; r < 16; ++r) xs[(d0 * 16 + r) * 64] = o[d0][r] * rl;
    }
    __syncthreads();
    if (map == 0) {
        float ss = 0.f;
#pragma unroll
        for (int d0 = 0; d0 < 4; ++d0)
#pragma unroll
            for (int r = 0; r < 16; ++r) { const float a = o[d0][r] * rl - lam * xs[(d0 * 16 + r) * 64]; o[d0][r] = a; ss += a * a; }
        { auto rr = __builtin_amdgcn_permlane32_swap(__float_as_uint(ss), __float_as_uint(ss), false, false); ss = __uint_as_float(rr[0]) + __uint_as_float(rr[1]); }
        const float rs = rsqrtf(ss * (1.0f / 128.0f) + RMS_EPS) * (1.0f - LAMBDA_INIT);
        bf16_t* Op = MIX + (size_t)(rowbase + qabs) * D + h * 128 + 4 * hi;
#pragma unroll
        for (int d0 = 0; d0 < 4; ++d0)
#pragma unroll
            for (int g = 0; g < 4; ++g) { const int dv = d0 * 32 + 8 * g + 4 * hi; const f32x4 sg = *(const f32x4*)(subln_g + dv);
                u32x2 w; w.x = pk2(o[d0][4 * g + 0] * rs * sg[0], o[d0][4 * g + 1] * rs * sg[1]); w.y = pk2(o[d0][4 * g + 2] * rs * sg[2], o[d0][4 * g + 3] * rs * sg[3]);
                *(u32x2*)(Op + d0 * 32 + 8 * g) = w; }
    }
    __syncthreads();
}
}

__device__ __forceinline__ void pool_strip(int strip, const bf16_t* QKVU, const float* b_pool, const float* pool_scale, bf16_t* MIX, int lane) {
    const int t0 = strip * 8, s0 = t0 % SEQ, g = lane >> 4, w = 2 << g;
    u32x4 raw[23];
#pragma unroll
    for (int i = 0; i < 23; ++i) { raw[i] = (u32x4){0u, 0u, 0u, 0u}; if (s0 + i - 15 >= 0) raw[i] = *(const u32x4*)(QKVU + (size_t)(t0 + i - 15) * NIN + 1536 + lane * 8); }
    float mk[16];
#pragma unroll
    for (int j = 0; j < 16; ++j) mk[j] = (j < w) ? 1.0f : 0.0f;
    const f32x4 b0 = *(const f32x4*)(b_pool + lane * 8), b1 = *(const f32x4*)(b_pool + lane * 8 + 4), sc0 = *(const f32x4*)(pool_scale + lane * 8), sc1 = *(const f32x4*)(pool_scale + lane * 8 + 4);
    u32x4 outp[8];
#pragma unroll
    for (int hf = 0; hf < 2; ++hf) {
        float v[23][4];
#pragma unroll
        for (int i = 0; i < 23; ++i) { const unsigned lo = hf ? raw[i].z : raw[i].x, hi = hf ? raw[i].w : raw[i].y;
            v[i][0] = __uint_as_float(lo << 16); v[i][1] = __uint_as_float(lo & 0xffff0000u); v[i][2] = __uint_as_float(hi << 16); v[i][3] = __uint_as_float(hi & 0xffff0000u); }
        const f32x4 bb = hf ? b1 : b0, ss = hf ? sc1 : sc0;
#pragma unroll
        for (int r = 0; r < 8; ++r) { float acc[4] = {0.f, 0.f, 0.f, 0.f};
#pragma unroll
            for (int j = 0; j < 16; ++j)
#pragma unroll
                for (int c = 0; c < 4; ++c) acc[c] += mk[j] * v[15 + r - j][c];
            const int pos1 = s0 + r + 1; const float inv = 1.0f / (float)(pos1 < w ? pos1 : w);
            float o[4];
#pragma unroll
            for (int c = 0; c < 4; ++c) o[c] = (acc[c] * inv - v[15 + r][c] + bb[c]) * ss[c];
            if (hf == 0) { outp[r].x = pk2(o[0], o[1]); outp[r].y = pk2(o[2], o[3]); } else { outp[r].z = pk2(o[0], o[1]); outp[r].w = pk2(o[2], o[3]); } }
    }
#pragma unroll
    for (int r = 0; r < 8; ++r) *(u32x4*)(MIX + (size_t)(t0 + r) * D + 512 + lane * 8) = outp[r];
}
__device__ __forceinline__ void fold_pool_item(const float* w_in, const float* w_pool, bf16_t* WINT, int g, int k0, int d0, int lane) {
    const int lr = lane & 15, lq = lane >> 4;
    f32x4 acc[4];
#pragma unroll
    for (int db = 0; db < 4; ++db) acc[db] = (f32x4){0.f, 0.f, 0.f, 0.f};
    const float* xr = w_in + (size_t)(k0 + lr) * NIN + 1536 + 128 * g + 4 * lq; const float* wpb = w_pool + (size_t)g * 16384 + d0 + lr;
#pragma unroll 2
    for (int c16 = 0; c16 < 8; ++c16) { const f32x4 x = *(const f32x4*)(xr + 16 * c16);
#pragma unroll
        for (int t = 0; t < 4; ++t)
#pragma unroll
            for (int db = 0; db < 4; ++db) { const float aw = wpb[(size_t)(16 * c16 + 4 * lq + t) * 128 + 16 * db]; acc[db] = __builtin_amdgcn_mfma_f32_16x16x4f32(aw, x[t], acc[db], 0, 0, 0); } }
#pragma unroll
    for (int db = 0; db < 4; ++db)
#pragma unroll
        for (int r = 0; r < 4; ++r) WINT[(size_t)(1536 + 128 * g + d0 + 16 * db + 4 * lq + r) * D + k0 + lr] = (bf16_t)(pk2(acc[db][r], 0.f) & 0xffffu);
}

__device__ __forceinline__ void transpose_item(const float* W, int N, int k0, int n0, bf16_t* WT, int K, int drow0, LAS float* scr, int lane) {
#pragma unroll 8
    for (int i = 0; i < 32; ++i) { const int kk = 2 * i + (lane >> 5); scr[kk * 33 + (lane & 31)] = W[(size_t)(k0 + kk) * N + n0 + (lane & 31)]; }
    asm volatile("s_waitcnt lgkmcnt(0)" ::: "memory");
    const int c = lane & 7;
#pragma unroll
    for (int j = 0; j < 4; ++j) { const int n = (lane >> 3) + 8 * j; const LAS float* s = scr + (8 * c) * 33 + n;
        u32x4 o; o.x = pk2(s[0 * 33], s[1 * 33]); o.y = pk2(s[2 * 33], s[3 * 33]); o.z = pk2(s[4 * 33], s[5 * 33]); o.w = pk2(s[6 * 33], s[7 * 33]);
        *(u32x4*)(WT + (size_t)(drow0 + n) * K + k0 + 8 * c) = o; }
    asm volatile("s_waitcnt lgkmcnt(0)" ::: "memory");
}
__device__ __forceinline__ void transpose_item_fp8(const float* W, int N, int k0, int n0, unsigned char* WT, int K, int drow0, LAS float* scr, int lane) {
#pragma unroll 8
    for (int i = 0; i < 32; ++i) { const int kk = 2 * i + (lane >> 5); scr[kk * 33 + (lane & 31)] = W[(size_t)(k0 + kk) * N + n0 + (lane & 31)]; }
    asm volatile("s_waitcnt lgkmcnt(0)" ::: "memory");
    const int c = lane & 3;
#pragma unroll
    for (int j = 0; j < 2; ++j) { const int n = (lane >> 2) + 16 * j; const LAS float* s = scr + (16 * c) * 33 + n;
        float v[16];
#pragma unroll
        for (int i = 0; i < 16; ++i) v[i] = clamp448(s[i * 33] * W_SCALE);
        u32x4 o; o.x = pk4_fp8(v[0], v[1], v[2], v[3]); o.y = pk4_fp8(v[4], v[5], v[6], v[7]); o.z = pk4_fp8(v[8], v[9], v[10], v[11]); o.w = pk4_fp8(v[12], v[13], v[14], v[15]);
        *(u32x4*)(WT + (size_t)(drow0 + n) * K + k0 + 16 * c) = o; }
    asm volatile("s_waitcnt lgkmcnt(0)" ::: "memory");
}
__device__ __forceinline__ void rms_row_to_bf16(const float* xrow, const float* g, bf16_t* orow, int lane) {
    const f32x4* xr = (const f32x4*)xrow + lane; const f32x4* gr = (const f32x4*)g + lane;
    f32x4 v[4]; float s = 0.f;
#pragma unroll
    for (int j = 0; j < 4; ++j) { v[j] = xr[64 * j]; s += (v[j].x * v[j].x + v[j].y * v[j].y) + (v[j].z * v[j].z + v[j].w * v[j].w); }
    const float rstd = rsqrtf(wave_sum(s) * (1.f / D) + RMS_EPS);
    u32x2* o8 = (u32x2*)orow + lane;
#pragma unroll
    for (int j = 0; j < 4; ++j) { const f32x4 gg = gr[64 * j]; u32x2 w; w.x = pk2(v[j].x * rstd * gg.x, v[j].y * rstd * gg.y); w.y = pk2(v[j].z * rstd * gg.z, v[j].w * rstd * gg.w); o8[64 * j] = w; }
}


#define XB_TMO      128
#define XB_XCNT(j)  (256  + 64 * (j))
#define XB_XSUB(j)  (1280 + 64 * (j))
#define XB_XGEN(j)  (2304 + 64 * (j))
#define XB_TOP      3328
#define XB_TOPGEN   3392
#define XCD_BAR_WORDS 3456
#define XB_SPIN_CAP (1u << 18)
__device__ __forceinline__ unsigned xb_ld(unsigned* p)              { return __hip_atomic_load(p, __ATOMIC_RELAXED, __HIP_MEMORY_SCOPE_AGENT); }
__device__ __forceinline__ unsigned xb_add(unsigned* p, unsigned v) { return __hip_atomic_fetch_add(p, v, __ATOMIC_RELAXED, __HIP_MEMORY_SCOPE_AGENT); }
__device__ __forceinline__ unsigned xb_xcc_id() { return (unsigned)__builtin_amdgcn_s_getreg((3 << 11) | 20) & 0xFu; }
#define XB_SPIN(cond, bar) do { unsigned _sp = 0; while (cond) { __builtin_amdgcn_s_sleep(1); \
    if ((++_sp & 255u) == 0u) { if (xb_ld(&(bar)[XB_TMO])) break; if (_sp > XB_SPIN_CAP) { atomicAdd(&(bar)[XB_TMO], 1u); break; } } } } while (0)
struct XcdBarrier { unsigned* bar; unsigned x; volatile LAS unsigned* st; };
__device__ __forceinline__ XcdBarrier xcd_barrier_post(unsigned* bar, volatile LAS unsigned* st) {
    XcdBarrier b; b.bar = bar; b.x = xb_xcc_id(); b.st = st;
    if (threadIdx.x == 0) (void)xb_add(&bar[XB_XCNT(b.x)], 1u);
    return b;
}
__device__ __forceinline__ void xcd_barrier_complete(unsigned* bar, unsigned x, unsigned& nloc, unsigned& nx) {
    const unsigned G = gridDim.x * gridDim.y * gridDim.z;
    unsigned sum, cnt, mine, sp = 0u;
    for (;;) {
        sum = 0u; cnt = 0u; mine = 0u;
#pragma unroll
        for (unsigned j = 0; j < 16; ++j) { const unsigned c = xb_ld(&bar[XB_XCNT(j)]); sum += c; cnt += (c > 0u) ? 1u : 0u; mine = (j == x) ? c : mine; }
        if (sum == G) break;
        __builtin_amdgcn_s_sleep(1);
        if ((++sp & 255u) == 0u) { if (xb_ld(&bar[XB_TMO])) break; if (sp > XB_SPIN_CAP) { atomicAdd(&bar[XB_TMO], 1u); break; } }
    }
    nloc = mine > 0u ? mine : 1u; nx = cnt > 0u ? cnt : 1u;
}
__device__ __forceinline__ void xcd_barrier(const XcdBarrier& b) {
    asm volatile("s_waitcnt vmcnt(0)" ::: "memory");
    __syncthreads();
    if (threadIdx.x == 0) {
        unsigned* bar = b.bar;
        __builtin_amdgcn_s_waitcnt(0);
        unsigned nloc = b.st[0], nx = b.st[1];
        if (nloc == 0u) { xcd_barrier_complete(bar, b.x, nloc, nx); b.st[0] = nloc; b.st[1] = nx; }
        const unsigned old = xb_add(&bar[XB_XSUB(b.x)], 1u);
        const unsigned gen = old / nloc;
        if (old + 1u == (gen + 1u) * nloc) {
            __builtin_amdgcn_fence(__ATOMIC_RELEASE, "agent");
            asm volatile("s_waitcnt vmcnt(0)" ::: "memory");
            const unsigned og = xb_add(&bar[XB_TOP], 1u);
            const unsigned tg = og / nx;
            if (og + 1u == (tg + 1u) * nx) xb_add(&bar[XB_TOPGEN], 1u);
            else XB_SPIN(xb_ld(&bar[XB_TOPGEN]) == tg, bar);
            __builtin_amdgcn_fence(__ATOMIC_ACQUIRE, "agent");
            xb_add(&bar[XB_XGEN(b.x)], 1u);
            asm volatile("s_waitcnt vmcnt(0)" ::: "memory");
        } else {
            XB_SPIN(xb_ld(&bar[XB_XGEN(b.x)]) == gen, bar);
            __builtin_amdgcn_fence(__ATOMIC_ACQUIRE, "agent");
            asm volatile("s_waitcnt vmcnt(0)" ::: "memory");
        }
    }
    __syncthreads();
}

struct Args {
    const float *x, *norm1_g, *w_in, *lq1, *lk1, *lq2, *lk2, *subln_g, *w_pool, *b_pool, *pool_scale, *w_out, *norm2_g, *router_w, *router_b,
                *w_gate, *b_gate, *w_up, *b_up, *w_down, *b_down, *final_g;
    float* out; unsigned char* ws; int ph_lo, ph_hi, bank, barslot;
};

__global__ void __launch_bounds__(512, 2) mk_fwd(Args a) {
    extern __shared__ __attribute__((aligned(16))) unsigned char lds_raw[];
    LAS unsigned char* lds = (LAS unsigned char*)lds_raw;
    const int tid = threadIdx.x, lane = tid & 63; const int wave = __builtin_amdgcn_readfirstlane(tid >> 6);
    const int G = gridDim.x, bx = blockIdx.x; const int vcu = (G % 8 == 0) ? (bx % 8) * (G / 8) + bx / 8 : bx;
    unsigned char* ws = a.ws;
    unsigned* ctl = (unsigned*)(ws + WS_CTL);
    bf16_t* WIN = (bf16_t*)(ws + WS_WIN); bf16_t* WOUT = (bf16_t*)(ws + WS_WOUT);
    bf16_t* WD = (bf16_t*)(ws + WS_WD); bf16_t* WGU = (bf16_t*)(ws + WS_WGU); bf16_t* ACT = (bf16_t*)(ws + WS_ACT);
    bf16_t* XN = (bf16_t*)(ws + WS_XN); bf16_t* QKVU = (bf16_t*)(ws + WS_QKVU); bf16_t* MIX = (bf16_t*)(ws + WS_MIX); bf16_t* Y = (bf16_t*)(ws + WS_Y);
    int* TOKE = (int*)(ws + WS_TOKE); int* TOKP = (int*)(ws + WS_TOKP); int* LTOK = (int*)(ws + WS_LTOK); float* LGATE = (float*)(ws + WS_LGATE);
#if PROBE_SUFFIX >= 0
    float* x1 = (float*)(ws + WS_ACT + 80 * MiB);
#else
    float* x1 = a.out;
#endif
    LAS int* ldsx = (LAS int*)(lds + LDSX_OFF);
    const int lo = a.ph_lo, hi = a.ph_hi;
#define IN(k) (lo <= (k) && (k) < hi)
#if MK_N_LAUNCHES == 1
    if (tid < 2) ldsx[248 + tid] = 0;
    __syncthreads();
    const XcdBarrier gbar = xcd_barrier_post(ctl + CW_BAR + a.barslot * XCD_BAR_WORDS, (volatile LAS unsigned*)(ldsx + 248));
#define GRID_BAR() do { xcd_barrier(gbar); } while (0)
#else
#define GRID_BAR() do { } while (0)
#endif
    const int gw = vcu * 8 + wave, NGW = G * 8;

    if (IN(0)) {
      for (int rep = 0; rep < REP0; ++rep) {
        LAS float* scr = (LAS float*)(lds + wave * 16384);
        constexpr int I_IN = 16 * 48, I_OUT = 512, I_POOL = 512, NITEMS = I_IN + I_OUT + I_POOL;
        for (int it = gw; it < NITEMS; it += NGW) {
            int r = it;
            if (r < I_IN) { const int kb = r / 48, nb = r % 48; transpose_item(a.w_in, NIN, kb * 64, nb * 32, WIN, D, nb * 32, scr, lane); continue; }
            r -= I_IN;
            if (r < I_OUT) { const int kb = r >> 5, nb = r & 31; transpose_item(a.w_out, D, kb * 64, nb * 32, WOUT, D, nb * 32, scr, lane); continue; }
            r -= I_OUT;
            { const int g = r >> 7, q = r & 127, kb = q >> 1, dh = q & 1; fold_pool_item(a.w_in, a.w_pool, WIN, g, kb * 16, dh * 64, lane); }
        }
        for (int m = gw; m < M; m += NGW) rms_row_to_bf16(a.x + (size_t)m * D, a.norm1_g, XN + (size_t)m * D, lane);
      }
        if (IN(1)) GRID_BAR();
    }

    if (IN(1)) {
        pg8::DenseSched S; S.init(M, NIN, D * 2, G, bx, WIN, REP1);
        pg8::EpiQkvu E{QKVU};
        pg8::gemm_phase<pg8::EpiQkvu, pg8::DenseSched, true, false>(lds, (const char*)XN, D * 2, S, E);
        if (IN(2)) GRID_BAR();
    }

    if (IN(2)) {
        float s1 = 0.f, s2 = 0.f;
        for (int i = 0; i < 64; ++i) { s1 += a.lq1[i] * a.lk1[i]; s2 += a.lq2[i] * a.lk2[i]; }
        const float lam = __expf(s1) - __expf(s2) + LAMBDA_INIT;
        att::ConvCtx cc{a.w_gate, a.w_up, a.w_down, (unsigned char*)WGU, (unsigned char*)WD, gw, NGW, -1, lds + 65536 + wave * 8192};
        for (int rep = 0; rep < REP2; ++rep) for (int p = vcu; p < 256; p += G) { const int bh = p >> 3, j = p & 7;
            att::attn_unit(bh >> 2, bh & 3, 15 - j, QKVU, MIX, lds, lam, a.subln_g, cc);
            att::attn_unit(bh >> 2, bh & 3, j, QKVU, MIX, lds, lam, a.subln_g, cc); }
        for (int base = cc.next - wave; base < att::CONV_ITEMS; base += NGW) { __syncthreads(); att::conv_finish(cc, lane); att::conv_issue(cc, lane); }
        __syncthreads(); att::conv_finish(cc, lane);
        for (int rep = 0; rep < REPPOOL; ++rep) for (int st = gw; st < M / 8; st += NGW) pool_strip(st, QKVU, a.b_pool, a.pool_scale, MIX, lane);
        if (IN(3)) GRID_BAR();
    }

    if (IN(3)) {
        pg8::DenseSched S; S.init(M, D, D * 2, G, bx, WOUT, REP3);
        pg8::EpiResF32 E{a.x, x1};
        pg8::gemm_phase<pg8::EpiResF32, pg8::DenseSched, true, false>(lds, (const char*)MIX, D * 2, S, E);
        if (IN(4)) GRID_BAR();
    }

    if (IN(4)) {
      for (int rep = 0; rep < REP4; ++rep) {
        const bool dummy = rep + 1 < REP4;
        unsigned* cntp = ctl + CW_CNT + 64 * a.bank + (dummy ? 32 : 0);
        int* LTOKw = dummy ? (int*)(ws + WS_ACT) : LTOK; float* LGATEw = dummy ? (float*)(ws + WS_ACT + 2 * MiB) : LGATE;
        int* TOKEw = dummy ? (int*)(ws + WS_ACT + 4 * MiB) : TOKE; int* TOKPw = dummy ? (int*)(ws + WS_ACT + 5 * MiB) : TOKP;
        __syncthreads();
        for (int it = tid; it < 1024 * 8; it += 512) { const int c = it >> 3, ch = it & 7; const f32x4 v = *(const f32x4*)(a.router_w + (size_t)c * NE + ch * 4);
            *(LAS f32x4*)(lds + (c ^ ((c >> 5) & 1)) * 128 + ((ch ^ ((c >> 2) & 7)) * 16)) = v; }
        if (tid < 32) ldsx[128 + tid] = 0;
        __syncthreads();
        LAS int* pend = (LAS int*)(lds + LDSX_OFF + 1024);
        LAS float* lgs = (LAS float*)(lds + LDSX_OFF + 5120) + wave * 96;
        unsigned char* H8 = (unsigned char*)XN;
        int nloc = 0;
        const int NP = M / 2;
        f32x4 na[4], nb[4];
        if (gw < NP) {
#pragma unroll
            for (int j = 0; j < 4; ++j) { na[j] = *((const f32x4*)(x1 + (size_t)(2 * gw) * D) + lane + 64 * j); nb[j] = *((const f32x4*)(x1 + (size_t)(2 * gw + 1) * D) + lane + 64 * j); }
        }
        const int sw = lane & 7;
        const int myexp = ((lane >> 5) & 1) * 16 + ((lane >> 4) & 1) * 8 + ((lane >> 3) & 1) * 4 + ((lane >> 2) & 1) * 2 + ((lane >> 1) & 1);
        const float myrb = a.router_b[myexp];
        for (int p = gw; p < NP; p += NGW, nloc += 2) {
            float ha[16], hb[16]; float ssa = 0.f, ssb = 0.f;
#pragma unroll
            for (int j = 0; j < 4; ++j) { ha[4 * j] = na[j].x; ha[4 * j + 1] = na[j].y; ha[4 * j + 2] = na[j].z; ha[4 * j + 3] = na[j].w; hb[4 * j] = nb[j].x; hb[4 * j + 1] = nb[j].y; hb[4 * j + 2] = nb[j].z; hb[4 * j + 3] = nb[j].w;
                ssa += (na[j].x * na[j].x + na[j].y * na[j].y) + (na[j].z * na[j].z + na[j].w * na[j].w); ssb += (nb[j].x * nb[j].x + nb[j].y * nb[j].y) + (nb[j].z * nb[j].z + nb[j].w * nb[j].w); }
            if (p + NGW < NP) {
#pragma unroll
                for (int j = 0; j < 4; ++j) { na[j] = *((const f32x4*)(x1 + (size_t)(2 * (p + NGW)) * D) + lane + 64 * j); nb[j] = *((const f32x4*)(x1 + (size_t)(2 * (p + NGW) + 1) * D) + lane + 64 * j); }
            }
#pragma unroll
            for (int o = 1; o < 64; o <<= 1) { ssa += __shfl_xor(ssa, o); ssb += __shfl_xor(ssb, o); }
            const float ra = rsqrtf(ssa * (1.f / D) + RMS_EPS), rb = rsqrtf(ssb * (1.f / D) + RMS_EPS);
#pragma unroll
            for (int j = 0; j < 4; ++j) { const f32x4 gg = *((const f32x4*)a.norm2_g + lane + 64 * j);
                ha[4 * j + 0] *= ra * gg.x; ha[4 * j + 1] *= ra * gg.y; ha[4 * j + 2] *= ra * gg.z; ha[4 * j + 3] *= ra * gg.w;
                hb[4 * j + 0] *= rb * gg.x; hb[4 * j + 1] *= rb * gg.y; hb[4 * j + 2] *= rb * gg.z; hb[4 * j + 3] *= rb * gg.w;
                *((unsigned*)(H8 + (size_t)(2 * p) * D) + lane + 64 * j) = pk4_fp8(clamp448(ha[4 * j + 0] * H_SCALE), clamp448(ha[4 * j + 1] * H_SCALE), clamp448(ha[4 * j + 2] * H_SCALE), clamp448(ha[4 * j + 3] * H_SCALE));
                *((unsigned*)(H8 + (size_t)(2 * p + 1) * D) + lane + 64 * j) = pk4_fp8(clamp448(hb[4 * j + 0] * H_SCALE), clamp448(hb[4 * j + 1] * H_SCALE), clamp448(hb[4 * j + 2] * H_SCALE), clamp448(hb[4 * j + 3] * H_SCALE)); }
            f32x2 la[16], lb[16];
#pragma unroll
            for (int e = 0; e < 16; ++e) { la[e] = (f32x2){0.f, 0.f}; lb[e] = (f32x2){0.f, 0.f}; }
#pragma unroll
            for (int q = 0; q < 16; ++q) { const int c = 4 * lane + 256 * (q >> 2) + (q & 3); const LAS unsigned char* rp = lds + (c ^ ((lane >> 3) & 1)) * 128;
                f32x4 w[8];
#pragma unroll
                for (int ch = 0; ch < 8; ++ch) w[ch] = *(const LAS f32x4*)(rp + ((ch ^ sw) * 16));
                const f32x2 a2 = (f32x2){ha[q], ha[q]}, b2 = (f32x2){hb[q], hb[q]};
#pragma unroll
                for (int ch = 0; ch < 8; ++ch) { const f32x2 wl = (f32x2){w[ch].x, w[ch].y}, wh = (f32x2){w[ch].z, w[ch].w};
                    la[2 * ch] = __builtin_elementwise_fma(wl, a2, la[2 * ch]); la[2 * ch + 1] = __builtin_elementwise_fma(wh, a2, la[2 * ch + 1]);
                    lb[2 * ch] = __builtin_elementwise_fma(wl, b2, lb[2 * ch]); lb[2 * ch + 1] = __builtin_elementwise_fma(wh, b2, lb[2 * ch + 1]); } }
            float logit[2];
#pragma unroll
            for (int rw = 0; rw < 2; ++rw) {
                float v32[32];
#pragma unroll
                for (int e = 0; e < 16; ++e) { v32[2 * e] = rw ? lb[e].x : la[e].x; v32[2 * e + 1] = rw ? lb[e].y : la[e].y; }
                float v16[16];
#pragma unroll
                for (int e = 0; e < 16; ++e) { const float mine = (lane & 32) ? v32[e + 16] : v32[e], oth = (lane & 32) ? v32[e] : v32[e + 16]; v16[e] = mine + __shfl_xor(oth, 32); }
                float v8[8];
#pragma unroll
                for (int e = 0; e < 8; ++e) { const float mine = (lane & 16) ? v16[e + 8] : v16[e], oth = (lane & 16) ? v16[e] : v16[e + 8]; v8[e] = mine + __shfl_xor(oth, 16); }
                float v4[4];
#pragma unroll
                for (int e = 0; e < 4; ++e) { const float mine = (lane & 8) ? v8[e + 4] : v8[e], oth = (lane & 8) ? v8[e] : v8[e + 4]; v4[e] = mine + __shfl_xor(oth, 8); }
                float v2[2];
#pragma unroll
                for (int e = 0; e < 2; ++e) { const float mine = (lane & 4) ? v4[e + 2] : v4[e], oth = (lane & 4) ? v4[e] : v4[e + 2]; v2[e] = mine + __shfl_xor(oth, 4); }
                float v1; { const float mine = (lane & 2) ? v2[1] : v2[0], oth = (lane & 2) ? v2[0] : v2[1]; v1 = mine + __shfl_xor(oth, 2); }
                v1 += __shfl_xor(v1, 1);
                logit[rw] = v1 + myrb;
                lgs[rw * 32 + myexp] = logit[rw];
            }
            asm volatile("s_waitcnt lgkmcnt(0)" ::: "memory");
#pragma unroll
            for (int rw = 0; rw < 2; ++rw) {
                int rank = 0;
#pragma unroll
                for (int c4 = 0; c4 < 8; ++c4) { const f32x4 t = *(const LAS f32x4*)(lgs + rw * 32 + c4 * 4);
#pragma unroll
                    for (int i = 0; i < 4; ++i) { const int eo = c4 * 4 + i; rank += (t[i] > logit[rw] || (t[i] == logit[rw] && eo < myexp)) ? 1 : 0; } }
                if (rank < 4 && (lane & 1) == 0) { lgs[64 + rw * 8 + rank * 2] = __int_as_float(myexp); lgs[64 + rw * 8 + rank * 2 + 1] = logit[rw]; }
            }
            asm volatile("s_waitcnt lgkmcnt(0)" ::: "memory");
            if (lane < 8) { const int rw = lane >> 2, k = lane & 3;
                const f32x4 s0 = *(const LAS f32x4*)(lgs + 64 + rw * 8), s1 = *(const LAS f32x4*)(lgs + 64 + rw * 8 + 4);
                const float e1 = __expf(s0.w - s0.y), e2 = __expf(s1.y - s0.y), e3 = __expf(s1.w - s0.y); const float inv = 1.0f / (1.0f + e1 + e2 + e3);
                const int e = __float_as_int(k == 0 ? s0.x : k == 1 ? s0.z : k == 2 ? s1.x : s1.z); const float gt = (k == 0 ? 1.0f : k == 1 ? e1 : k == 2 ? e2 : e3) * inv;
                const int rank = __hip_atomic_fetch_add((LAS int*)(ldsx + 128 + e), 1, __ATOMIC_RELAXED, __HIP_MEMORY_SCOPE_WORKGROUP);
                LAS int* pe = pend + ((wave * 8 + nloc + rw) * 4 + k) * 4; pe[0] = e; pe[1] = rank; pe[2] = __float_as_int(gt); pe[3] = 2 * p + rw; }
            asm volatile("s_waitcnt lgkmcnt(0)" ::: "memory");
        }
        if (lane == 0) ldsx[224 + wave] = nloc;
        __syncthreads();
        if (tid < 32) ldsx[192 + tid] = (int)atomicAdd(cntp + tid, (unsigned)ldsx[128 + tid]);
        __syncthreads();
        if (tid < 256) { const int w8 = tid >> 5, rem = tid & 31, nl = rem >> 2, k = rem & 3;
            if (nl < ldsx[224 + w8]) { LAS int* pe = pend + ((w8 * 8 + nl) * 4 + k) * 4; const int e = pe[0], pos = ldsx[192 + e] + pe[1], m = pe[3];
                LTOKw[(size_t)e * M + pos] = m; LGATEw[(size_t)e * M + pos] = __int_as_float(pe[2]); TOKEw[m * 4 + k] = e; TOKPw[m * 4 + k] = pos; } }
      }
        if (IN(5)) GRID_BAR();
    }

    if (IN(5) || IN(6) || IN(7)) {
        __syncthreads();
        if (tid < 32) ldsx[64 + tid] = (int)__hip_atomic_load(ctl + CW_CNT + 64 * a.bank + tid, __ATOMIC_RELAXED, __HIP_MEMORY_SCOPE_AGENT);
        __syncthreads();
        if (tid == 0) { int acc = 0; for (int e = 0; e < NE; ++e) { ldsx[e] = acc; acc += (ldsx[64 + e] + 255) >> 8; } ldsx[NE] = acc; }
        __syncthreads();
    }

    if (IN(5)) {
        pg8::MoeSched S{ldsx, ldsx + 64, 8, vcu / (G / 8), vcu % (G / 8), D, (const char*)WGU, (size_t)2048 * D, LTOK, true};
        pg8::EpiSwiglu E{(unsigned char*)ACT, a.b_gate, a.b_up};
        for (int rep = 0; rep < REP5; ++rep) pg8::gemm_phase<pg8::EpiSwiglu, pg8::MoeSched, true, true>(lds, (const char*)XN, D, S, E);
        if (IN(6)) GRID_BAR();
    }

    if (IN(6)) {
        pg8::MoeSched S{ldsx, ldsx + 64, 4, vcu / (G / 8), vcu % (G / 8), DFF, (const char*)WD, (size_t)D * DFF, LTOK, false};
        pg8::EpiDown E{Y, a.b_down, LGATE, ldsx};
        for (int rep = 0; rep < REP6; ++rep) pg8::gemm_phase<pg8::EpiDown, pg8::MoeSched, true, true>(lds, (const char*)ACT, DFF, S, E);
        if (IN(7)) GRID_BAR();
    }

    if (IN(7)) {
      for (int rep = 0; rep < REP7; ++rep) {
        float* outp = (rep + 1 < REP7) ? (float*)(ws + WS_ACT) : a.out;
        for (int m = gw; m < M; m += NGW) {
            const bf16_t* yr[4];
#pragma unroll
            for (int k = 0; k < 4; ++k) { const int e = TOKE[m * 4 + k], pos = TOKP[m * 4 + k]; yr[k] = Y + ((size_t)ldsx[e] * 256 + pos) * D; }
            f32x4 v[4]; float ss = 0.f;
#pragma unroll
            for (int j = 0; j < 4; ++j) { v[j] = *((const f32x4*)(x1 + (size_t)m * D) + lane + 64 * j);
#pragma unroll
                for (int k = 0; k < 4; ++k) { const u32x2 yv = *((const u32x2*)yr[k] + lane + 64 * j);
                    v[j].x += __uint_as_float(yv.x << 16); v[j].y += __uint_as_float(yv.x & 0xffff0000u); v[j].z += __uint_as_float(yv.y << 16); v[j].w += __uint_as_float(yv.y & 0xffff0000u); }
                ss += (v[j].x * v[j].x + v[j].y * v[j].y) + (v[j].z * v[j].z + v[j].w * v[j].w); }
            const float rstd = rsqrtf(wave_sum(ss) * (1.f / D) + RMS_EPS);
#pragma unroll
            for (int j = 0; j < 4; ++j) { const f32x4 gg = *((const f32x4*)a.final_g + lane + 64 * j); *((f32x4*)(outp + (size_t)m * D) + lane + 64 * j) = v[j] * rstd * gg; }
        }
      }
    }
#undef IN
#undef GRID_BAR
}

extern "C" void kernel_launch(void* const* d_in, const int* in_sizes, int n_in, void* d_out, int out_size, void* d_ws, size_t ws_size, hipStream_t stream) {
    static int grid = 0;
    if (grid == 0) {
        if (n_in != 22 || in_sizes[0] != M * D || out_size != M * D || ws_size < WS_END) { fprintf(stderr, "kernel_launch: unexpected shapes / workspace (n_in %d, ws %zu)\n", n_in, ws_size); grid = -1; return; }
        int dev = 0, cus = 0, per_cu = 0;
        (void)hipGetDevice(&dev); (void)hipDeviceGetAttribute(&cus, hipDeviceAttributeMultiprocessorCount, dev);
        (void)hipFuncSetAttribute((const void*)mk_fwd, hipFuncAttributeMaxDynamicSharedMemorySize, LDS_BYTES);
        (void)hipOccupancyMaxActiveBlocksPerMultiprocessor(&per_cu, (const void*)mk_fwd, 512, LDS_BYTES);
        (void)hipGetLastError();
        if (per_cu < 1) { fprintf(stderr, "kernel_launch: occupancy query says %d blocks per CU\n", per_cu); grid = -1; return; }
        grid = cus;
        if (grid % 8 != 0) grid -= grid % 8;
    }
    if (grid < 0) return;
    (void)hipMemsetAsync((char*)d_ws + WS_CTL, 0, CTL_ZERO_BYTES, stream);
    Args a{};
    const float** f = (const float**)&a;
    for (int i = 0; i < 22; ++i) f[i] = (const float*)d_in[i];
    a.out = (float*)d_out; a.ws = (unsigned char*)d_ws;
#if MK_N_LAUNCHES == 1
    a.ph_lo = 0; a.ph_hi = 8;
    void* args[] = {&a};
    hipError_t e = hipLaunchCooperativeKernel((const void*)mk_fwd, dim3(grid), dim3(512), args, LDS_BYTES, stream);
    if (e != hipSuccess) fprintf(stderr, "cooperative launch failed: %s (grid %d)\n", hipGetErrorString(e), grid);
#if PROBE_SUFFIX >= 0
    a.ph_lo = PROBE_SUFFIX; a.bank = (PROBE_SUFFIX <= 4) ? 1 : 0; a.barslot = 1;
    e = hipLaunchCooperativeKernel((const void*)mk_fwd, dim3(grid), dim3(512), args, LDS_BYTES, stream);
    if (e != hipSuccess) fprintf(stderr, "cooperative launch 2 failed: %s (grid %d)\n", hipGetErrorString(e), grid);
#endif
#else
    for (int p = 0; p < 8; ++p) { a.ph_lo = p; a.ph_hi = p + 1; hipLaunchKernelGGL(mk_fwd, dim3(grid), dim3(512), LDS_BYTES, stream, a); }
#endif
}
```
